# Optimizing an MI355X kernel written in HIP

```python
import numpy as np
import jax, jax.numpy as jnp
from jax import lax

D_MODEL = 1024
BATCH = 4
SEQ = 8192
DEPTH = 4

HEAD_DIM = 64
NSA_HEADS = 8
NSA_KV_GROUPS = 2
NSA_HPG = NSA_HEADS // NSA_KV_GROUPS
CMP_BLOCK = 32
CMP_STRIDE = 16
CMP_HIDDEN = 256
SEL_BLOCK = 64
SEL_TOPK = 16
NSA_WINDOW = 512
Q_BLOCK = 128
FORCE_SCORE = 1e6
DIL_GROUPS = ((128, 1), (512, 4), (2048, 16))
DIL_HPG = 4
DIL_HEADS = DIL_HPG * len(DIL_GROUPS)
DIL_BLOCK = 128
D_FF = -(-8 * D_MODEL // (3 * 256)) * 256
NSA_Q = NSA_HEADS * HEAD_DIM
NSA_KV = 3 * 2 * NSA_KV_GROUPS * HEAD_DIM
NSA_GATE = NSA_HEADS * 3
DIL_QKV = 3 * DIL_HEADS * HEAD_DIM
MERGE_GATE = 2 * D_MODEL
IN_SPLITS = tuple(int(c) for c in np.cumsum([NSA_Q, NSA_KV, NSA_GATE, DIL_QKV]))
D_IN = NSA_Q + NSA_KV + NSA_GATE + DIL_QKV + MERGE_GATE
NSA_OUT = NSA_HEADS * HEAD_DIM
DIL_OUT = DIL_HPG * HEAD_DIM
N_ALIBI = NSA_HEADS + DIL_HEADS
EPS = 1e-6
NEG_INF = -1e30
TINY = 1e-30

kernel_name = "hybrid_nsa_dilated_alibi_trunk"


def rmsnorm(x, g):
    xf = x.astype(jnp.float32)
    y = xf * lax.rsqrt(jnp.mean(xf * xf, axis=-1, keepdims=True) + EPS)
    return (y * g.astype(jnp.float32)).astype(x.dtype)


def alibi_slopes():
    k = jnp.arange(1, N_ALIBI + 1, dtype=jnp.float32)
    s = jnp.exp2(-8.0 * k / N_ALIBI)
    d0 = s[:DIL_HPG]
    d1 = s[DIL_HPG:2 * DIL_HPG]
    nsa = s[2 * DIL_HPG:2 * DIL_HPG + NSA_HEADS]
    d2 = s[2 * DIL_HPG + NSA_HEADS:]
    return nsa, (d0, d1, d2)


def masked_softmax(s, mask):
    s = jnp.where(mask, s, NEG_INF)
    m = jnp.max(s, axis=-1, keepdims=True)
    e = jnp.where(mask, jnp.exp(s - m), 0.0)
    l = jnp.sum(e, axis=-1, keepdims=True)
    lt = jnp.maximum(l, TINY)
    return e / lt, (m + jnp.log(lt))[..., 0]


def compress(kv, pe, w1, w2):
    B, S, G, hd = kv.shape
    n_c = (S - CMP_BLOCK) // CMP_STRIDE + 1
    idx = jnp.arange(n_c)[:, None] * CMP_STRIDE + jnp.arange(CMP_BLOCK)[None, :]
    blk = kv[:, idx] + pe[:, None, :]
    blk = blk.transpose(0, 1, 3, 2, 4).reshape(B, n_c, G, CMP_BLOCK * hd)
    return jax.nn.silu(blk @ w1) @ w2


def nsa_attention(q, kvs, gates, pe_k, pe_v, w_ck1, w_ck2, w_cv1, w_cv2, slopes):
    B, S, H, hd = q.shape
    G, Hg = NSA_KV_GROUPS, NSA_HPG
    k_cmp, v_cmp = kvs[:, :, 0, 0], kvs[:, :, 0, 1]
    k_slc, v_slc = kvs[:, :, 1, 0], kvs[:, :, 1, 1]
    k_win, v_win = kvs[:, :, 2, 0], kvs[:, :, 2, 1]
    kc = compress(k_cmp, pe_k, w_ck1, w_ck2)
    vc = compress(v_cmp, pe_v, w_cv1, w_cv2)
    n_c = kc.shape[1]
    n_s = S // SEL_BLOCK
    n_top = min(SEL_TOPK, n_s)
    c_start = jnp.arange(n_c) * CMP_STRIDE
    pos_c = (c_start + CMP_BLOCK - 1).astype(jnp.float32)
    s_start = jnp.arange(n_s) * SEL_BLOCK
    overlap = jnp.clip(jnp.minimum(c_start[:, None] + CMP_BLOCK, s_start[None, :] + SEL_BLOCK)
                       - jnp.maximum(c_start[:, None], s_start[None, :]), 0).astype(jnp.float32) / CMP_BLOCK
    kb = k_slc.reshape(B, n_s, SEL_BLOCK, G, hd).transpose(0, 3, 1, 2, 4)
    vb = v_slc.reshape(B, n_s, SEL_BLOCK, G, hd).transpose(0, 3, 1, 2, 4)
    pad_w = ((0, 0), (NSA_WINDOW, 0), (0, 0), (0, 0))
    kw = jnp.pad(k_win, pad_w)
    vw = jnp.pad(v_win, pad_w)
    qs = (q * (hd ** -0.5)).reshape(B, S, G, Hg, hd)
    gs = gates.reshape(B, S, G, Hg, 3)
    m = slopes.reshape(G, Hg)[:, :, None, None]
    bi = jnp.arange(B)[:, None, None, None]
    gi = jnp.arange(G)[None, :, None, None]
    j = jnp.arange(n_s)

    def block(i):
        s0 = i * Q_BLOCK
        qb = lax.dynamic_slice_in_dim(qs, s0, Q_BLOCK, axis=1)
        gb = lax.dynamic_slice_in_dim(gs, s0, Q_BLOCK, axis=1)
        t = s0 + jnp.arange(Q_BLOCK)
        tf = t.astype(jnp.float32)
        sc = jnp.einsum('bqghd,bngd->bghqn', qb, kc).astype(jnp.float32)
        dc = tf[:, None] - pos_c[None, :]
        pc, _ = masked_softmax(sc - m * dc, dc >= 0)
        o_c = jnp.einsum('bghqn,bngd->bqghd', pc, vc)
        imp = jnp.einsum('bghqn,nj->bgqj', pc, overlap)
        jt = t // SEL_BLOCK
        valid = j[None, :] <= jt[:, None]
        forced = (j[None, :] == 0) | (j[None, :] == jt[:, None]) | (j[None, :] == jt[:, None] - 1)
        score = jnp.where(forced, FORCE_SCORE, jnp.where(valid, imp, -1.0))
        top, idx = lax.top_k(score, n_top)
        ks = kb[bi, gi, idx]
        vs = vb[bi, gi, idx]
        pos_s = idx[..., None] * SEL_BLOCK + jnp.arange(SEL_BLOCK)
        ds = (t[:, None, None] - pos_s).astype(jnp.float32)
        mask_s = ((top >= 0)[..., None] & (ds >= 0)).reshape(B, G, 1, Q_BLOCK, n_top * SEL_BLOCK)
        ss = jnp.einsum('bqghd,bgqnld->bghqnl', qb, ks).astype(jnp.float32)
        ss = ss.reshape(B, G, Hg, Q_BLOCK, n_top * SEL_BLOCK)
        ps, _ = masked_softmax(ss - m[None] * ds.reshape(B, G, 1, Q_BLOCK, n_top * SEL_BLOCK), mask_s)
        o_s = jnp.einsum('bghqk,bgqkd->bqghd', ps, vs.reshape(B, G, Q_BLOCK, n_top * SEL_BLOCK, hd))
        kwb = lax.dynamic_slice_in_dim(kw, s0, Q_BLOCK + NSA_WINDOW, axis=1)
        vwb = lax.dynamic_slice_in_dim(vw, s0, Q_BLOCK + NSA_WINDOW, axis=1)
        pos_w = s0 - NSA_WINDOW + jnp.arange(Q_BLOCK + NSA_WINDOW)
        dw = t[:, None] - pos_w[None, :]
        mask_w = (dw >= 0) & (dw < NSA_WINDOW) & (pos_w[None, :] >= 0)
        sw = jnp.einsum('bqghd,bkgd->bghqk', qb, kwb).astype(jnp.float32)
        pw, _ = masked_softmax(sw - m * dw.astype(jnp.float32), mask_w)
        o_w = jnp.einsum('bghqk,bkgd->bqghd', pw, vwb)
        o = gb[..., 0:1] * o_c + gb[..., 1:2] * o_s + gb[..., 2:3] * o_w
        return o.reshape(B, Q_BLOCK, H * hd)

    out = lax.map(block, jnp.arange(S // Q_BLOCK))
    return out.transpose(1, 0, 2, 3).reshape(B, S, H * hd)


def dilated_group(q, k, v, window, dil, slopes):
    B, S, Hg, hd = q.shape
    L = S // dil
    steps = window // dil
    c = DIL_BLOCK
    nb = -(-L // c)
    Lp = nb * c

    def sub(a):
        a = a.reshape(B, L, dil, Hg, hd).transpose(0, 2, 3, 1, 4)
        return jnp.pad(a, ((0, 0), (0, 0), (0, 0), (0, Lp - L), (0, 0)))

    def band(a):
        ap = jnp.pad(sub(a), ((0, 0), (0, 0), (0, 0), (c, 0), (0, 0)))
        prev = ap[:, :, :, :Lp].reshape(B, dil, Hg, nb, c, hd)
        cur = ap[:, :, :, c:].reshape(B, dil, Hg, nb, c, hd)
        return jnp.concatenate([prev, cur], axis=4)

    qs = (sub(q) * (hd ** -0.5)).reshape(B, dil, Hg, nb, c, hd)
    kband, vband = band(k), band(v)
    s = jnp.einsum('brhnqd,brhnkd->brhnqk', qs, kband).astype(jnp.float32)
    qi = jnp.arange(c)
    ki = jnp.arange(2 * c)
    delta = qi[:, None] + c - ki[None, :]
    k_abs = jnp.arange(nb)[:, None] * c - c + ki[None, :]
    mask = (delta >= 0)[None] & (delta <= steps)[None] & (k_abs[:, None, :] >= 0)
    bias = slopes[:, None, None, None] * (delta * dil).astype(jnp.float32)[None, None]
    p, lse = masked_softmax(s - bias, mask)
    o = jnp.einsum('brhnqk,brhnkd->brhnqd', p, vband).reshape(B, dil, Hg, Lp, hd)[:, :, :, :L]
    o = o.transpose(0, 3, 1, 2, 4).reshape(B, S, Hg, hd)
    lse = lse.reshape(B, dil, Hg, Lp)[..., :L].transpose(0, 3, 1, 2).reshape(B, S, Hg)
    return o, lse


def setup_inputs(seed: int = 0) -> dict:
    key = jax.random.key(seed)
    ks = jax.random.split(key, 16)

    def nrm(k, shape, fan):
        return jax.random.normal(k, shape, jnp.float32) * (fan ** -0.5)

    def gain(k, shape):
        return 1.0 + 0.01 * jax.random.normal(k, shape, jnp.float32)

    return {
        "x": jax.random.normal(ks[0], (BATCH, SEQ, D_MODEL), jnp.float32),
        "norm_mix": gain(ks[1], (DEPTH, D_MODEL)),
        "w_in": nrm(ks[2], (DEPTH, D_MODEL, D_IN), D_MODEL),
        "pe_k": 0.1 * jax.random.normal(ks[3], (DEPTH, CMP_BLOCK, HEAD_DIM), jnp.float32),
        "pe_v": 0.1 * jax.random.normal(ks[4], (DEPTH, CMP_BLOCK, HEAD_DIM), jnp.float32),
        "w_ck1": nrm(ks[5], (DEPTH, CMP_BLOCK * HEAD_DIM, CMP_HIDDEN), CMP_BLOCK * HEAD_DIM),
        "w_ck2": nrm(ks[6], (DEPTH, CMP_HIDDEN, HEAD_DIM), CMP_HIDDEN),
        "w_cv1": nrm(ks[7], (DEPTH, CMP_BLOCK * HEAD_DIM, CMP_HIDDEN), CMP_BLOCK * HEAD_DIM),
        "w_cv2": nrm(ks[8], (DEPTH, CMP_HIDDEN, HEAD_DIM), CMP_HIDDEN),
        "w_up_nsa": nrm(ks[9], (DEPTH, NSA_OUT, D_MODEL), NSA_OUT),
        "w_up_dil": nrm(ks[10], (DEPTH, DIL_OUT, D_MODEL), DIL_OUT),
        "w_out": nrm(ks[11], (DEPTH, D_MODEL, D_MODEL), D_MODEL),
        "norm_ffn": gain(ks[12], (DEPTH, D_MODEL)),
        "w_ffn_in": nrm(ks[13], (DEPTH, D_MODEL, 2 * D_FF), D_MODEL),
        "w_ffn_out": nrm(ks[14], (DEPTH, D_FF, D_MODEL), D_FF),
        "norm_final": gain(ks[15], (D_MODEL,)),
    }


def reference(x, norm_mix, w_in, pe_k, pe_v, w_ck1, w_ck2, w_cv1, w_cv2, w_up_nsa, w_up_dil,
              w_out, norm_ffn, w_ffn_in, w_ffn_out, norm_final):
    B, S, D = x.shape
    slopes_nsa, slopes_dil = alibi_slopes()
    for l in range(DEPTH):
        h = rmsnorm(x, norm_mix[l])
        proj = h @ w_in[l]
        q_a, kv_a, g_a, qkv_b, g_m = jnp.split(proj, IN_SPLITS, axis=-1)
        q_a = q_a.reshape(B, S, NSA_HEADS, HEAD_DIM)
        kv_a = kv_a.reshape(B, S, 3, 2, NSA_KV_GROUPS, HEAD_DIM)
        g_a = jax.nn.sigmoid(g_a).reshape(B, S, NSA_HEADS, 3)
        y_a = nsa_attention(q_a, kv_a, g_a, pe_k[l], pe_v[l], w_ck1[l], w_ck2[l],
                            w_cv1[l], w_cv2[l], slopes_nsa)
        qkv_b = qkv_b.reshape(B, S, 3, len(DIL_GROUPS), DIL_HPG, HEAD_DIM)
        outs, lses = [], []
        for gidx, (window, dil) in enumerate(DIL_GROUPS):
            o_g, lse_g = dilated_group(qkv_b[:, :, 0, gidx], qkv_b[:, :, 1, gidx],
                                       qkv_b[:, :, 2, gidx], window, dil, slopes_dil[gidx])
            outs.append(o_g)
            lses.append(lse_g)
        wts = jax.nn.softmax(jnp.stack(lses, axis=-1), axis=-1)
        y_b = jnp.sum(jnp.stack(outs, axis=-1) * wts[..., None, :], axis=-1).reshape(B, S, DIL_OUT)
        gate_a, gate_b = jnp.split(jax.nn.sigmoid(g_m), 2, axis=-1)
        merged = gate_a * (y_a @ w_up_nsa[l]) + gate_b * (y_b @ w_up_dil[l])
        x = x + (merged @ w_out[l]).astype(x.dtype)
        h = rmsnorm(x, norm_ffn[l])
        gt, up = jnp.split(h @ w_ffn_in[l], 2, axis=-1)
        x = x + ((jax.nn.silu(gt) * up) @ w_ffn_out[l]).astype(x.dtype)
    return rmsnorm(x, norm_final)
```

```cpp
#include <hip/hip_runtime.h>
#include <hip/hip_cooperative_groups.h>
#include <cstdio>
#include <cstdint>
namespace cg = cooperative_groups;
namespace pg8 {
#define PG8_LAS __attribute__((address_space(3)))
typedef unsigned short bf16_t;
typedef short bf16x8 __attribute__((ext_vector_type(8)));
typedef float f32x4 __attribute__((ext_vector_type(4)));
typedef unsigned u32x4 __attribute__((ext_vector_type(4)));
constexpr int BM = 256, BK = 64, HALF = 128, HTB = HALF * BK * 2  , STAGE_BYTES = 8 * HTB, NXCD = 8, WGM = 8;

__host__ __device__ __forceinline__ int lds_byte(int r, int c) { const int st = (r >> 4) * 2 + (c >> 5), rr = r & 15, cc = c & 31, ob = rr * 64 + cc * 2; return st * 1024 + (ob ^ (((ob >> 9) & 1) << 5)); }
__host__ __device__ __forceinline__ void stage_rc(int b, int& R, int& C) { const int st = b / 1024, sb = b % 1024, swz = sb ^ (((sb >> 9) & 1) << 5); R = (st >> 1) * 16 + swz / 64; C = (st & 1) * 32 + (swz % 64) / 2; }
__host__ __device__ __forceinline__ int perm32(int rho) { const int n = rho >> 4, i = rho & 15; return 8 * (i >> 2) + 4 * n + (i & 3); }

__device__ __forceinline__ int pg8_tid() { int t = threadIdx.x; asm volatile("" : "+v"(t)); return t; }
struct Unit { int pm, pn; };
struct Gemm { const bf16_t* A; const bf16_t* Bt; int M, N, K, lda, ldb; };

struct StaticOrder {
    int nM, nN, nwg, G, c;
    __host__ __device__ void init(int M, int N, int G_, int c_) { nM = M / BM; nN = N / BM; nwg = nM * nN; G = G_; c = c_; }
    __host__ __device__ bool next(int i, Unit& u) const {
        const long L = (long)i * G + c; if (L >= nwg) return false;
        int wgid = (int)L; { const int q = nwg / NXCD, r = nwg % NXCD, xcd = wgid % NXCD, off = wgid / NXCD; wgid = (xcd < r ? xcd * (q + 1) : r * (q + 1) + (xcd - r) * q) + off; }
        const int nig = WGM * nN, gid = wgid / nig, fm = gid * WGM, gsz = (nM - fm) < WGM ? (nM - fm) : WGM;
        u.pm = fm + ((wgid % nig) % gsz); u.pn = (wgid % nig) / gsz; return true;
    }
    __device__ __forceinline__ void a_ready(const Unit&) const {}
    __device__ __forceinline__ void done(const Unit&) const {}
};
template <class Epi, class Sched, bool ALIGN_EPI = false, bool SP2 = false>
__device__ __forceinline__ void gemm_phase(PG8_LAS unsigned char* lds, const Gemm g, const Sched& S, const Epi& E) {
    const int tid = pg8_tid(), wid = __builtin_amdgcn_readfirstlane(tid >> 6), lane = tid & 63, wr = wid >> 2, wc = wid & 3, fr = lane & 15, fq = lane >> 4;
    const int K = g.K, nt = K / BK;
    unsigned voffA[2], voffB[2];
#pragma unroll
    for (int i = 0; i < 2; ++i) { int R, C; stage_rc(tid * 16 + i * 8192, R, C); const int Rb = Epi::PERM ? ((R & ~31) + perm32(R & 31)) : R;
        voffA[i] = (unsigned)(R * g.lda + C) * 2u; voffB[i] = (unsigned)(Rb * g.ldb + C) * 2u; }
    const size_t kstep = (size_t)(BK * 2);
    const size_t hstepB = (size_t)HALF * g.ldb * 2, hstepA = (size_t)HALF * g.lda * 2;
    const size_t tstepB = 2 * hstepB, tstepA = 2 * hstepA;
    const unsigned ldsw = (unsigned)wid * 1024u;
    const int aoff = lds_byte(wr * 64 + fr, fq * 8), boff = lds_byte(wc * 32 + fr, fq * 8);
#define PG8_SA(b, h) (((b) * 2 + (h)) * HTB)
#define PG8_SB(b, h) ((4 + (b) * 2 + (h)) * HTB)
#define PG8_STAGE(bufoff, gbase, voff) do { _Pragma("unroll") for (int _i = 0; _i < 2; ++_i) \
        __builtin_amdgcn_global_load_lds((const unsigned*)((const char*)(gbase) + (voff)[_i]), (PG8_LAS unsigned*)(lds + (bufoff) + ldsw + _i * 8192), 16, 0, 0); } while (0)
#define PG8_LDA(dst, b, h) do { _Pragma("unroll") for (int m = 0; m < 4; ++m) _Pragma("unroll") for (int k = 0; k < 2; ++k) dst[m][k] = *(const PG8_LAS bf16x8*)(lds + PG8_SA(b, h) + aoff + m * 2048 + k * 1024); } while (0)
#define PG8_LDB(dst, b, h) do { _Pragma("unroll") for (int n = 0; n < 2; ++n) _Pragma("unroll") for (int k = 0; k < 2; ++k) dst[n][k] = *(const PG8_LAS bf16x8*)(lds + PG8_SB(b, h) + boff + n * 2048 + k * 1024); } while (0)
#define PG8_MMA(ai, bj, At, Bt) do { __builtin_amdgcn_s_setprio(1); _Pragma("unroll") for (int m = 0; m < 4; ++m) _Pragma("unroll") for (int n = 0; n < 2; ++n) _Pragma("unroll") for (int k = 0; k < 2; ++k) \
        acc[ai][bj][m][n] = __builtin_amdgcn_mfma_f32_16x16x32_bf16(Bt[n][k], At[m][k], acc[ai][bj][m][n], 0, 0, 0); __builtin_amdgcn_s_setprio(0); } while (0)
#define PG8_WAIT_V(n) asm volatile("s_waitcnt vmcnt(" #n ")" ::: "memory")
#define PG8_WAIT_L(n) asm volatile("s_waitcnt lgkmcnt(" #n ")" ::: "memory")
#define PG8_BAR __builtin_amdgcn_s_barrier()
#define PG8_SCHED __builtin_amdgcn_sched_barrier(0)
    Unit cur, nxt; int ui = 0;
    if (!S.next(0, cur)) return;
    f32x4 acc[2][2][4][2];
#pragma unroll
    for (int a = 0; a < 2; ++a)
#pragma unroll
        for (int b = 0; b < 2; ++b)
#pragma unroll
            for (int m = 0; m < 4; ++m)
#pragma unroll
                for (int n = 0; n < 2; ++n) acc[a][b][m][n] = (f32x4){0.f, 0.f, 0.f, 0.f};
    bf16x8 At[4][2], B0[2][2], B1[2][2];
    const char* cA = (const char*)g.A + (size_t)cur.pm * tstepA; const char* cB = (const char*)g.Bt + (size_t)cur.pn * tstepB;
    S.a_ready(cur);
    if constexpr (SP2) {
        PG8_STAGE(PG8_SB(0, 0), cB, voffB); PG8_STAGE(PG8_SB(0, 1), cB + hstepB, voffB); PG8_STAGE(PG8_SA(0, 0), cA, voffA); PG8_STAGE(PG8_SA(0, 1), cA + hstepA, voffA);
        if (wr == 1) PG8_BAR;
        PG8_WAIT_V(2); PG8_BAR;
        PG8_STAGE(PG8_SB(1, 0), cB + kstep, voffB); PG8_STAGE(PG8_SA(1, 0), cA + kstep, voffA); PG8_STAGE(PG8_SB(1, 1), cB + hstepB + kstep, voffB);
        PG8_WAIT_V(6); PG8_BAR;
    } else {
        PG8_STAGE(PG8_SB(0, 0), cB, voffB); PG8_STAGE(PG8_SA(0, 0), cA, voffA); PG8_STAGE(PG8_SB(0, 1), cB + hstepB, voffB); PG8_STAGE(PG8_SA(0, 1), cA + hstepA, voffA);
        if (wr == 1) PG8_BAR;
        PG8_WAIT_V(4); PG8_BAR;
        PG8_STAGE(PG8_SB(1, 0), cB + kstep, voffB); PG8_STAGE(PG8_SA(1, 0), cA + kstep, voffA); PG8_STAGE(PG8_SB(1, 1), cB + hstepB + kstep, voffB);
        PG8_WAIT_V(6); PG8_BAR;
    }
    for (;;) {
        const bool has_next = S.next(ui + 1, nxt);
        const char* nA = has_next ? (const char*)g.A + (size_t)nxt.pm * tstepA : cA; const char* nB = has_next ? (const char*)g.Bt + (size_t)nxt.pn * tstepB : cB;
        for (int t = 0; t < nt; t += 2) {
            const bool last = (t == nt - 2);
            const char* a1 = cA + (size_t)(t + 1) * kstep;
            const char* a2 = last ? nA : cA + (size_t)(t + 2) * kstep; const char* b2 = last ? nB : cB + (size_t)(t + 2) * kstep;
            const char* a3 = a2 + kstep; const char* b3 = b2 + kstep;
            if (last && has_next) S.a_ready(nxt);
            if constexpr (SP2) {
            PG8_LDB(B0, 0, 0); PG8_LDB(B1, 0, 1); PG8_SCHED; PG8_LDA(At, 0, 0); PG8_STAGE(PG8_SA(1, 1), a1 + hstepA, voffA);
            PG8_WAIT_V(8); PG8_WAIT_L(0); PG8_BAR; PG8_MMA(0, 0, At, B0); PG8_MMA(0, 1, At, B1); PG8_BAR; PG8_SCHED;
            PG8_LDA(At, 0, 1); PG8_STAGE(PG8_SB(0, 0), b2, voffB); PG8_STAGE(PG8_SB(0, 1), b2 + hstepB, voffB); PG8_STAGE(PG8_SA(0, 0), a2, voffA);
            PG8_WAIT_V(8); PG8_WAIT_L(0); PG8_BAR; PG8_MMA(1, 0, At, B0); PG8_MMA(1, 1, At, B1); PG8_BAR; PG8_SCHED;
            PG8_LDB(B0, 1, 0); PG8_LDB(B1, 1, 1); PG8_SCHED; PG8_LDA(At, 1, 0); PG8_STAGE(PG8_SA(0, 1), a2 + hstepA, voffA);
            PG8_WAIT_V(8); PG8_WAIT_L(0); PG8_BAR; PG8_MMA(0, 0, At, B0); PG8_MMA(0, 1, At, B1); PG8_BAR; PG8_SCHED;
            PG8_LDA(At, 1, 1); PG8_STAGE(PG8_SB(1, 0), b3, voffB); PG8_STAGE(PG8_SB(1, 1), b3 + hstepB, voffB); PG8_STAGE(PG8_SA(1, 0), a3, voffA);
            PG8_WAIT_V(8); PG8_WAIT_L(0); PG8_BAR; PG8_MMA(1, 0, At, B0); PG8_MMA(1, 1, At, B1); PG8_BAR; PG8_SCHED;
            } else {
            PG8_LDB(B0, 0, 0); PG8_SCHED; PG8_LDA(At, 0, 0); PG8_STAGE(PG8_SA(1, 1), a1 + hstepA, voffA);
            PG8_WAIT_L(8); PG8_BAR; PG8_WAIT_L(0); PG8_MMA(0, 0, At, B0); PG8_BAR; PG8_SCHED;
            PG8_LDB(B1, 0, 1); PG8_STAGE(PG8_SB(0, 0), b2, voffB);
            PG8_BAR; PG8_WAIT_L(0); PG8_MMA(0, 1, At, B1); PG8_BAR;
            PG8_LDA(At, 0, 1); PG8_STAGE(PG8_SA(0, 0), a2, voffA);
            PG8_BAR; PG8_WAIT_L(0); PG8_MMA(1, 0, At, B0); PG8_BAR; PG8_SCHED;
            PG8_STAGE(PG8_SB(0, 1), b2 + hstepB, voffB);
            PG8_WAIT_V(6); PG8_BAR; PG8_MMA(1, 1, At, B1); PG8_BAR;
            PG8_LDB(B0, 1, 0); PG8_SCHED; PG8_LDA(At, 1, 0); PG8_STAGE(PG8_SA(0, 1), a2 + hstepA, voffA);
            PG8_WAIT_L(8); PG8_BAR; PG8_WAIT_L(0); PG8_MMA(0, 0, At, B0); PG8_BAR; PG8_SCHED;
            PG8_LDB(B1, 1, 1); PG8_STAGE(PG8_SB(1, 0), b3, voffB);
            PG8_BAR; PG8_WAIT_L(0); PG8_MMA(0, 1, At, B1); PG8_BAR;
            PG8_LDA(At, 1, 1); PG8_STAGE(PG8_SA(1, 0), a3, voffA);
            PG8_BAR; PG8_WAIT_L(0); PG8_MMA(1, 0, At, B0); PG8_BAR; PG8_SCHED;
            PG8_STAGE(PG8_SB(1, 1), b3 + hstepB, voffB);
            PG8_WAIT_V(6); PG8_BAR; PG8_MMA(1, 1, At, B1); PG8_BAR;
            }
        }
        if constexpr (ALIGN_EPI) { if (wr == 0) PG8_BAR; }
        if constexpr (!Epi::AFTER_DRAIN) { E(acc, cur, wr, wc, fr, fq); S.done(cur); }
        if (!has_next) break;
#pragma unroll
        for (int a = 0; a < 2; ++a)
#pragma unroll
            for (int b = 0; b < 2; ++b)
#pragma unroll
                for (int m = 0; m < 4; ++m)
#pragma unroll
                    for (int n = 0; n < 2; ++n) acc[a][b][m][n] = (f32x4){0.f, 0.f, 0.f, 0.f};
        cur = nxt; cA = nA; cB = nB; ++ui;
        if constexpr (ALIGN_EPI) { if (wr == 1) PG8_BAR; }
    }
    PG8_WAIT_V(0);
    if constexpr (!ALIGN_EPI) { if (wr == 0) PG8_BAR; }
    PG8_BAR;
    if constexpr (Epi::AFTER_DRAIN) { E.fused(acc, cur, wr, wc, fr, fq, lds, wid, lane); S.done(cur); }
#undef PG8_SA
#undef PG8_SB
#undef PG8_STAGE
#undef PG8_LDA
#undef PG8_LDB
#undef PG8_MMA
#undef PG8_WAIT_V
#undef PG8_WAIT_L
#undef PG8_BAR
#undef PG8_SCHED
}
}
#define DI __device__ __forceinline__
#define GAS __attribute__((address_space(1)))
#define LAS __attribute__((address_space(3)))
typedef unsigned short bf16;
typedef short bf16x8 __attribute__((ext_vector_type(8)));
typedef float f32x4 __attribute__((ext_vector_type(4)));
typedef float f32x16 __attribute__((ext_vector_type(16)));
typedef float f32x2 __attribute__((ext_vector_type(2)));
typedef unsigned u32x4 __attribute__((ext_vector_type(4)));
typedef unsigned u32x2 __attribute__((ext_vector_type(2)));
typedef __bf16 bf2_t __attribute__((ext_vector_type(2)));
using pg8::Unit; using pg8::Gemm;

constexpr int BATCH = 4, SEQ = 8192, DM = 1024, DEPTH = 4, NTOK = BATCH * SEQ, DFF = 2816;
constexpr int D_IN = 5656, N_IN_PAD = 3840, NPR = 57;
constexpr float LOG2E = 1.4426950408889634f, C2 = 0.125f * 1.4426950408889634f, EPS = 1e-6f;
constexpr size_t MiB = 1u << 20;
constexpr size_t WS_RSUM = 1 * MiB, WS_BIAS = 3 * MiB, WS_KC = 4 * MiB, WS_VCT = 4 * MiB + 512 * 1024, WS_H = 5 * MiB;
constexpr size_t WS_W0 = 10 * MiB, WS_W1 = 44 * MiB, WS_XB = 78 * MiB, WS_Y = 142 * MiB, WS_VT = 190 * MiB, WS_PR = 254 * MiB;
constexpr size_t WS_TA = WS_PR, WS_TB = WS_PR + 64 * MiB, WS_MG = WS_PR + 128 * MiB, WS_ACT = WS_PR, WS_PART = 482 * MiB, WS_END = 498 * MiB;
constexpr size_t W_IN = 0, W_G = W_IN + (size_t)3840 * 1024, W_FF = W_G + (size_t)2048 * 1024, W_FO = W_FF + (size_t)5632 * 1024, W_O = W_FO + (size_t)1024 * 2816,
                 W_UA = W_O + (size_t)1024 * 1024, W_UB = W_UA + (size_t)1024 * 512, W_CK1 = W_UB + (size_t)1024 * 256, W_CV1 = W_CK1 + (size_t)256 * 2048,
                 W_CK2 = W_CV1 + (size_t)256 * 2048, W_CV2 = W_CK2 + (size_t)256 * 256, W_TOTAL = W_CV2 + (size_t)256 * 256;
static_assert(W_TOTAL * 2 <= 34 * MiB, "weight set");
constexpr int LDS_BYTES = 163840;

struct Args { const float* p[18]; };

DI unsigned pk2(float lo, float hi) { f32x2 v = {lo, hi}; return __builtin_bit_cast(unsigned, __builtin_convertvector(v, bf2_t)); }
DI float bf2f(unsigned short b) { return __uint_as_float((unsigned)b << 16); }
DI float fast_exp2(float x) { return __builtin_amdgcn_exp2f(x); }
DI float sigmoidf_(float x) { return __builtin_amdgcn_rcpf(1.f + fast_exp2(-x * LOG2E)); }
DI float siluf_(float x) { return x * sigmoidf_(x); }
DI int launder_i(int v) { asm volatile("" : "+s"(v)); return v; }
DI float wave_sum(float v) {
#pragma unroll
    for (int o = 1; o < 64; o <<= 1) v += __shfl_xor(v, o);
    return v;
}
#define LDS_WAIT() asm volatile("s_waitcnt lgkmcnt(0)" ::: "memory")

typedef const f32x4 (&AccRef)[2][2][4][2];
DI float load_rs1(const float* rsum, int row) {
    const GAS f32x4* p = (const GAS f32x4*)(rsum + (size_t)row * 16);
    const f32x4 a = p[0], b = p[1], c = p[2], d = p[3];
    const float s = (((a.x + a.y) + (a.z + a.w)) + ((b.x + b.y) + (b.z + b.w))) + (((c.x + c.y) + (c.z + c.w)) + ((d.x + d.y) + (d.z + d.w)));
    return rsqrtf(s * (1.f / 1024.f) + EPS);
}
DI void unit_rs_table(const float* rsum, int pm, LAS float* rsl) {
    const int tid = pg8::pg8_tid();
    if (tid < 256) rsl[tid] = load_rs1(rsum, pm * 256 + tid);
    asm volatile("s_waitcnt lgkmcnt(0)\n\ts_barrier" ::: "memory");
}
DI void load_rs(const float* rsum, int row0, float (&rs)[2][4]) {
#pragma unroll
    for (int ai = 0; ai < 2; ++ai)
#pragma unroll
        for (int m = 0; m < 4; ++m) {
            const GAS f32x4* p = (const GAS f32x4*)(rsum + (size_t)(row0 + ai * 128 + m * 16) * 16);
            const f32x4 a = p[0], b = p[1], c = p[2], d = p[3];
            const float s = (((a.x + a.y) + (a.z + a.w)) + ((b.x + b.y) + (b.z + b.w))) + (((c.x + c.y) + (c.z + c.w)) + ((d.x + d.y) + (d.z + d.w)));
            rs[ai][m] = rsqrtf(s * (1.f / 1024.f) + EPS);
        }
}
struct EpiProj {
    static constexpr bool PERM = true, AFTER_DRAIN = false;
    bf16* PR; const float* rsum; LAS float* rsl;
    DI void operator()(AccRef acc, const Unit& u, int wr, int wc, int fr, int fq) const {
        const int row0 = u.pm * 256 + wr * 64 + fr;
        unit_rs_table(rsum, u.pm, rsl);
#pragma unroll
        for (int ai = 0; ai < 2; ++ai)
#pragma unroll
            for (int m = 0; m < 4; ++m) {
                const int row = row0 + ai * 128 + m * 16; const float rs = rsl[row - u.pm * 256];
#pragma unroll
                for (int bj = 0; bj < 2; ++bj) {
                    const int c0 = u.pn * 256 + bj * 128 + wc * 32 + 8 * fq, cb = c0 >> 6;
                    if (cb >= NPR) continue;
                    const float sc = (cb < 8 || (cb >= 20 && cb < 32)) ? C2 : 1.f; const bool sig = (cb == 56);
                    const float f = rs * sc;
                    f32x4 v0 = acc[ai][bj][m][0] * f, v1 = acc[ai][bj][m][1] * f;
                    if (sig) { for (int i = 0; i < 4; ++i) { v0[i] = sigmoidf_(v0[i]); v1[i] = sigmoidf_(v1[i]); } }
                    u32x4 w; w.x = pk2(v0[0], v0[1]); w.y = pk2(v0[2], v0[3]); w.z = pk2(v1[0], v1[1]); w.w = pk2(v1[2], v1[3]);
                    if (cb >= 32 && cb < 44) {
                        const int dsh = ((cb - 32) >> 2) * 2, t = row & (SEQ - 1), p = ((t & ((1 << dsh) - 1)) << (13 - dsh)) + (t >> dsh), ch = (c0 & 63) >> 3;
                        *(GAS u32x4*)(PR + ((size_t)cb * NTOK + (size_t)(row - t)) * 64 + (size_t)(p >> 5) * 2048 + ((((ch >> 1) * 32 + (p & 31)) * 2 + (ch & 1)) * 8)) = w;
                    } else
                    *(GAS u32x4*)(PR + ((size_t)cb * NTOK + row) * 64 + (c0 & 63)) = w;
                }
            }
    }
};
template <int ACT> struct EpiBf {
    static constexpr bool PERM = true, AFTER_DRAIN = false;
    bf16* O; int ldc; const float* bias;
    DI void operator()(AccRef acc, const Unit& u, int wr, int wc, int fr, int fq) const {
        const int row0 = u.pm * 256 + wr * 64 + fr;
#pragma unroll
        for (int bj = 0; bj < 2; ++bj) {
            const int c0 = u.pn * 256 + bj * 128 + wc * 32 + 8 * fq;
            f32x4 b0 = {0.f, 0.f, 0.f, 0.f}, b1 = b0;
            if (ACT) { b0 = *(const GAS f32x4*)(bias + c0); b1 = *(const GAS f32x4*)(bias + c0 + 4); }
#pragma unroll
            for (int ai = 0; ai < 2; ++ai)
#pragma unroll
                for (int m = 0; m < 4; ++m) {
                    const int row = row0 + ai * 128 + m * 16;
                    f32x4 v0 = acc[ai][bj][m][0] + b0, v1 = acc[ai][bj][m][1] + b1;
                    if (ACT) { for (int i = 0; i < 4; ++i) { v0[i] = siluf_(v0[i]); v1[i] = siluf_(v1[i]); } }
                    u32x4 w; w.x = pk2(v0[0], v0[1]); w.y = pk2(v0[2], v0[3]); w.z = pk2(v1[0], v1[1]); w.w = pk2(v1[2], v1[3]);
                    *(GAS u32x4*)(O + (size_t)row * ldc + c0) = w;
                }
        }
    }
};
struct EpiCmp {
    static constexpr bool PERM = true, AFTER_DRAIN = false;
    bf16* O; int mode;
    DI void operator()(AccRef acc, const Unit& u, int wr, int wc, int fr, int fq) const {
        if (u.pn != 0 || wc >= 2) return;
        const int row0 = u.pm * 256 + wr * 64 + fr; const int c0 = wc * 32 + 8 * fq;
#pragma unroll
        for (int ai = 0; ai < 2; ++ai)
#pragma unroll
            for (int m = 0; m < 4; ++m) {
                const int row = row0 + ai * 128 + m * 16;
                const f32x4 v0 = acc[ai][0][m][0], v1 = acc[ai][0][m][1];
                if (mode == 0) {
                    u32x4 w; w.x = pk2(v0[0], v0[1]); w.y = pk2(v0[2], v0[3]); w.z = pk2(v1[0], v1[1]); w.w = pk2(v1[2], v1[3]);
                    *(GAS u32x4*)(O + (size_t)row * 64 + c0) = w;
                } else {
                    GAS bf16* p = (GAS bf16*)O + ((size_t)(row >> 9) * 64 + c0) * 512 + (row & 511);
#pragma unroll
                    for (int i = 0; i < 4; ++i) { p[(size_t)i * 512] = (bf16)(pk2(v0[i], 0.f) & 0xffffu); p[(size_t)(4 + i) * 512] = (bf16)(pk2(v1[i], 0.f) & 0xffffu); }
                }
            }
    }
};
struct EpiGate {
    static constexpr bool PERM = true, AFTER_DRAIN = false;
    const bf16* Ta; const bf16* Tb; bf16* MG; const float* rsum; LAS float* rsl;
    DI void operator()(AccRef acc, const Unit& u, int wr, int wc, int fr, int fq) const {
        const int row0 = u.pm * 256 + wr * 64 + fr; const int c0 = u.pn * 128 + wc * 32 + 8 * fq;
        unit_rs_table(rsum, u.pm, rsl);
#pragma unroll
        for (int ai = 0; ai < 2; ++ai) {
            u32x4 ta[4], tb[4];
#pragma unroll
            for (int m = 0; m < 4; ++m) { const size_t off = (size_t)(row0 + ai * 128 + m * 16) * DM + c0; ta[m] = *(const GAS u32x4*)(Ta + off); tb[m] = *(const GAS u32x4*)(Tb + off); }
#pragma unroll
            for (int m = 0; m < 4; ++m) {
                const int row = row0 + ai * 128 + m * 16; const float f = rsl[row - u.pm * 256];
                float o[8];
#pragma unroll
                for (int i = 0; i < 8; ++i) {
                    const float ga = acc[ai][0][m][i >> 2][i & 3] * f, gb = acc[ai][1][m][i >> 2][i & 3] * f;
                    const unsigned wa = ta[m][i >> 1], wb = tb[m][i >> 1];
                    const float a = (i & 1) ? __uint_as_float(wa & 0xffff0000u) : __uint_as_float(wa << 16);
                    const float b = (i & 1) ? __uint_as_float(wb & 0xffff0000u) : __uint_as_float(wb << 16);
                    o[i] = sigmoidf_(ga) * a + sigmoidf_(gb) * b;
                }
                u32x4 w; w.x = pk2(o[0], o[1]); w.y = pk2(o[2], o[3]); w.z = pk2(o[4], o[5]); w.w = pk2(o[6], o[7]);
                *(GAS u32x4*)(MG + (size_t)row * DM + c0) = w;
            }
        }
    }
};
struct EpiSwiglu {
    static constexpr bool PERM = true, AFTER_DRAIN = false;
    bf16* ACT; const float* rsum; LAS float* rsl;
    DI void operator()(AccRef acc, const Unit& u, int wr, int wc, int fr, int fq) const {
        const int row0 = u.pm * 256 + wr * 64 + fr; const int c0 = u.pn * 128 + wc * 32 + 8 * fq;
        unit_rs_table(rsum, u.pm, rsl);
#pragma unroll
        for (int ai = 0; ai < 2; ++ai)
#pragma unroll
            for (int m = 0; m < 4; ++m) {
                const int row = row0 + ai * 128 + m * 16; const float f = rsl[row - u.pm * 256];
                float o[8];
#pragma unroll
                for (int i = 0; i < 8; ++i) { const float gt = acc[ai][0][m][i >> 2][i & 3] * f, up = acc[ai][1][m][i >> 2][i & 3] * f; o[i] = siluf_(gt) * up; }
                u32x4 w; w.x = pk2(o[0], o[1]); w.y = pk2(o[2], o[3]); w.z = pk2(o[4], o[5]); w.w = pk2(o[6], o[7]);
                *(GAS u32x4*)(ACT + (size_t)row * DFF + c0) = w;
            }
    }
};
struct EpiResid {
    static constexpr bool PERM = true, AFTER_DRAIN = false;
    bf16* xb; float* rsum;
    DI void operator()(AccRef acc, const Unit& u, int wr, int wc, int fr, int fq) const {
        const int row0 = u.pm * 256 + wr * 64 + fr;
#pragma unroll
        for (int ai = 0; ai < 2; ++ai) {
            u32x4 xr[4][2];
#pragma unroll
            for (int m = 0; m < 4; ++m)
#pragma unroll
                for (int bj = 0; bj < 2; ++bj) xr[m][bj] = *(const GAS u32x4*)(xb + (size_t)(row0 + ai * 128 + m * 16) * DM + u.pn * 256 + bj * 128 + wc * 32 + 8 * fq);
#pragma unroll
            for (int m = 0; m < 4; ++m) {
                const int row = row0 + ai * 128 + m * 16; float ss = 0.f;
#pragma unroll
                for (int bj = 0; bj < 2; ++bj) {
                    const int c0 = u.pn * 256 + bj * 128 + wc * 32 + 8 * fq; const size_t off = (size_t)row * DM + c0;
                    float v[8];
#pragma unroll
                    for (int i = 0; i < 4; ++i) { v[2 * i] = __uint_as_float(xr[m][bj][i] << 16) + acc[ai][bj][m][(2 * i) >> 2][(2 * i) & 3]; v[2 * i + 1] = __uint_as_float(xr[m][bj][i] & 0xffff0000u) + acc[ai][bj][m][(2 * i + 1) >> 2][(2 * i + 1) & 3]; }
                    u32x4 w; w.x = pk2(v[0], v[1]); w.y = pk2(v[2], v[3]); w.z = pk2(v[4], v[5]); w.w = pk2(v[6], v[7]);
                    *(GAS u32x4*)(xb + off) = w;
#pragma unroll
                    for (int i = 0; i < 4; ++i) { const float lo = __uint_as_float(w[i] << 16), hi_ = __uint_as_float(w[i] & 0xffff0000u); ss += lo * lo + hi_ * hi_; }
                }
                ss += __shfl_xor(ss, 16); ss += __shfl_xor(ss, 32);
                if (fq == 0) rsum[(size_t)row * 16 + u.pn * 4 + wc] = ss;
            }
        }
    }
};
struct EpiF32 {
    static constexpr bool PERM = true, AFTER_DRAIN = false;
    float* O; int ldc;
    DI void operator()(AccRef acc, const Unit& u, int wr, int wc, int fr, int fq) const {
        const int row0 = u.pm * 256 + wr * 64 + fr;
#pragma unroll
        for (int bj = 0; bj < 2; ++bj) {
            const int c0 = u.pn * 256 + bj * 128 + wc * 32 + 8 * fq;
#pragma unroll
            for (int ai = 0; ai < 2; ++ai)
#pragma unroll
                for (int m = 0; m < 4; ++m) { GAS f32x4* p = (GAS f32x4*)(O + (size_t)(row0 + ai * 128 + m * 16) * ldc + c0); p[0] = acc[ai][bj][m][0]; p[1] = acc[ai][bj][m][1]; }
        }
    }
};
struct EpiGa {
    static constexpr bool PERM = true, AFTER_DRAIN = false;
    bf16* PR; const float* rsum;
    DI void operator()(AccRef acc, const Unit& u, int wr, int wc, int fr, int fq) const {
        if (wc != 0 || fq >= 3) return;
        const int row0 = u.pm * 256 + wr * 64 + fr;
#pragma unroll
        for (int ai = 0; ai < 2; ++ai)
#pragma unroll
            for (int m = 0; m < 4; ++m) {
                const int row = row0 + ai * 128 + m * 16; const float f = load_rs1(rsum, row);
                f32x4 v0 = acc[ai][0][m][0] * f, v1 = acc[ai][0][m][1] * f;
#pragma unroll
                for (int i = 0; i < 4; ++i) { v0[i] = sigmoidf_(v0[i]); v1[i] = sigmoidf_(v1[i]); }
                u32x4 w; w.x = pk2(v0[0], v0[1]); w.y = pk2(v0[2], v0[3]); w.z = pk2(v1[0], v1[1]); w.w = pk2(v1[2], v1[3]);
                *(GAS u32x4*)(PR + ((size_t)56 * NTOK + row) * 64 + 8 * fq) = w;
            }
    }
};
struct OneUnit { int pm, pn, has;
    DI bool next(int i, Unit& u) const { if (i > 0 || !has) return false; u.pm = pm; u.pn = pn; return true; }
    DI void a_ready(const Unit&) const {} DI void done(const Unit&) const {} };
struct PanelOrder { int per, G, c;
    DI bool next(int i, Unit& u) const { const int hp = c + (i / per) * G; if (hp >= 2 * (NTOK / 256)) return false; u.pm = hp >> 1; u.pn = (hp & 1) * per + (i % per); return true; }
    DI void a_ready(const Unit&) const {} DI void done(const Unit&) const {} };
#define XB_TMO      128
#define XB_XCNT(j)  (256  + 64 * (j))
#define XB_XSUB(j)  (1280 + 64 * (j))
#define XB_XGEN(j)  (2304 + 64 * (j))
#define XB_TOP      3328
#define XB_TOPGEN   3392
#define XCD_BAR_WORDS 3456
#define XB_SPIN_CAP (1u << 23)

__device__ __forceinline__ unsigned xb_ld(unsigned* p)              { return __hip_atomic_load(p, __ATOMIC_RELAXED, __HIP_MEMORY_SCOPE_AGENT); }
__device__ __forceinline__ unsigned xb_add(unsigned* p, unsigned v) { return __hip_atomic_fetch_add(p, v, __ATOMIC_RELAXED, __HIP_MEMORY_SCOPE_AGENT); }
__device__ __forceinline__ unsigned xb_xcc_id() { return (unsigned)__builtin_amdgcn_s_getreg((3 << 11) | 20) & 0xFu; }
#define XB_SPIN(cond, bar) do { unsigned _sp = 0; while (cond) { __builtin_amdgcn_s_sleep(1); \
    if ((++_sp & 255u) == 0u) { if (xb_ld(&(bar)[XB_TMO])) break; if (_sp > XB_SPIN_CAP) { atomicAdd(&(bar)[XB_TMO], 1u); break; } } } } while (0)

struct XcdBarrier {
    unsigned* bar; unsigned x;
    volatile LAS unsigned* st;
};

__device__ __forceinline__ XcdBarrier xcd_barrier_post(unsigned* bar, volatile LAS unsigned* st) {
    XcdBarrier b; b.bar = bar; b.x = xb_xcc_id(); b.st = st;
    if (threadIdx.x == 0) (void)xb_add(&bar[XB_XCNT(b.x)], 1u);
    return b;
}
__device__ __forceinline__ void xcd_barrier_complete(unsigned* bar, unsigned x, unsigned& nloc, unsigned& nx) {
    const unsigned G = gridDim.x * gridDim.y * gridDim.z;
    unsigned sum, cnt, mine, sp = 0u;
    for (;;) {
        sum = 0u; cnt = 0u; mine = 0u;
#pragma unroll
        for (unsigned j = 0; j < 16; ++j) { const unsigned c = xb_ld(&bar[XB_XCNT(j)]); sum += c; cnt += (c > 0u) ? 1u : 0u; mine = (j == x) ? c : mine; }
        if (sum == G) break;
        __builtin_amdgcn_s_sleep(1);
        if ((++sp & 255u) == 0u) { if (xb_ld(&bar[XB_TMO])) break; if (sp > XB_SPIN_CAP) { atomicAdd(&bar[XB_TMO], 1u); break; } }
    }
    nloc = mine > 0u ? mine : 1u; nx = cnt > 0u ? cnt : 1u;
}

__device__ __forceinline__ void xcd_barrier(const XcdBarrier& b) {
    asm volatile("s_waitcnt vmcnt(0)" ::: "memory");
    __syncthreads();
    if (threadIdx.x == 0) {
        unsigned* bar = b.bar;
        __builtin_amdgcn_s_waitcnt(0);
        unsigned nloc = b.st[0], nx = b.st[1];
        if (nloc == 0u) { xcd_barrier_complete(bar, b.x, nloc, nx); b.st[0] = nloc; b.st[1] = nx; }
        const unsigned old = xb_add(&bar[XB_XSUB(b.x)], 1u);
        const unsigned gen = old / nloc;
        if (old + 1u == (gen + 1u) * nloc) {
            __builtin_amdgcn_fence(__ATOMIC_RELEASE, "agent");
            asm volatile("s_waitcnt vmcnt(0)" ::: "memory");
            const unsigned og = xb_add(&bar[XB_TOP], 1u);
            const unsigned tg = og / nx;
            if (og + 1u == (tg + 1u) * nx) xb_add(&bar[XB_TOPGEN], 1u);
            else XB_SPIN(xb_ld(&bar[XB_TOPGEN]) == tg, bar);
            __builtin_amdgcn_fence(__ATOMIC_ACQUIRE, "agent");
            xb_add(&bar[XB_XGEN(b.x)], 1u);
            asm volatile("s_waitcnt vmcnt(0)" ::: "memory");
        } else {
            XB_SPIN(xb_ld(&bar[XB_XGEN(b.x)]) == gen, bar);
            __builtin_amdgcn_fence(__ATOMIC_ACQUIRE, "agent");
            asm volatile("s_waitcnt vmcnt(0)" ::: "memory");
        }
    }
    __syncthreads();
}
DI int srcmap(int mt, int n) {
    switch (mt) {
        case 0: return n < 1280 ? n : (n < 3584 ? n + 24 : (n < 3608 ? n - 3584 + 1280 : -1));
        case 1: { const int tile = n >> 8, w = n & 255, c = tile * 128 + (w & 127); return 3608 + (w < 128 ? c : 1024 + c); }
        case 2: { const int tile = n >> 8, w = n & 255, c = tile * 128 + (w & 127); return (w < 128) ? c : DFF + c; }
        case 9: case 10: return n < 64 ? n : -1;
        default: return n;
    }
}
DI void cvt_item(const float* W, int Nsrc, int K, const float* gain, int mt, bf16* WT, LAS float* scr, int item, int lane) {
    const int kblks = K >> 6; const int nb = item / kblks, kb = item - nb * kblks; const int k0 = 64 * kb, n0 = 32 * nb;
    const int nn = lane & 31; const int col = srcmap(mt, n0 + nn);
    float vals[32];
#pragma unroll
    for (int i = 0; i < 32; ++i) { const int kk = 2 * i + (lane >> 5); vals[i] = (col >= 0) ? W[(size_t)(k0 + kk) * Nsrc + col] : 0.f; }
    if (gain) {
#pragma unroll
        for (int i = 0; i < 32; ++i) vals[i] *= gain[k0 + 2 * i + (lane >> 5)]; }
#pragma unroll
    for (int i = 0; i < 32; ++i) scr[(2 * i + (lane >> 5)) * 33 + nn] = vals[i];
    LDS_WAIT();
    const int c = lane & 7;
#pragma unroll
    for (int j = 0; j < 4; ++j) { const int n = (lane >> 3) + 8 * j; const LAS float* s = scr + (8 * c) * 33 + n;
        u32x4 o; o.x = pk2(s[0 * 33], s[1 * 33]); o.y = pk2(s[2 * 33], s[3 * 33]); o.z = pk2(s[4 * 33], s[5 * 33]); o.w = pk2(s[6 * 33], s[7 * 33]);
        *(GAS u32x4*)(WT + (size_t)(n0 + n) * K + k0 + 8 * c) = o; }
    LDS_WAIT();
}
constexpr int CVT_ITEMS = 1920 + 1024 + 2816 + 1408 + 512 + 256 + 128 + 256 + 256 + 32 + 32;
DI void convert_layer(const Args& a, int l, bf16* wset, LAS float* scr, int first, int stride, int lane, int it_end = CVT_ITEMS) {
    for (int it = first; it < it_end; it += stride) {
        int r = it, mt, src, Nsrc, K; size_t loff, woff;
        if (r < 1920) { mt = 0; src = 2; Nsrc = D_IN; K = 1024; loff = (size_t)DM * D_IN; woff = W_IN; }
        else if ((r -= 1920) < 1024) { mt = 1; src = 2; Nsrc = D_IN; K = 1024; loff = (size_t)DM * D_IN; woff = W_G; }
        else if ((r -= 1024) < 2816) { mt = 2; src = 13; Nsrc = 2 * DFF; K = 1024; loff = (size_t)DM * 2 * DFF; woff = W_FF; }
        else if ((r -= 2816) < 1408) { mt = 3; src = 14; Nsrc = DM; K = DFF; loff = (size_t)DFF * DM; woff = W_FO; }
        else if ((r -= 1408) < 512) { mt = 4; src = 11; Nsrc = DM; K = 1024; loff = (size_t)DM * DM; woff = W_O; }
        else if ((r -= 512) < 256) { mt = 5; src = 9; Nsrc = DM; K = 512; loff = (size_t)512 * DM; woff = W_UA; }
        else if ((r -= 256) < 128) { mt = 6; src = 10; Nsrc = DM; K = 256; loff = (size_t)256 * DM; woff = W_UB; }
        else if ((r -= 128) < 256) { mt = 7; src = 5; Nsrc = 256; K = 2048; loff = (size_t)2048 * 256; woff = W_CK1; }
        else if ((r -= 256) < 256) { mt = 8; src = 7; Nsrc = 256; K = 2048; loff = (size_t)2048 * 256; woff = W_CV1; }
        else if ((r -= 256) < 32) { mt = 9; src = 6; Nsrc = 64; K = 256; loff = (size_t)256 * 64; woff = W_CK2; }
        else { r -= 32; mt = 10; src = 8; Nsrc = 64; K = 256; loff = (size_t)256 * 64; woff = W_CV2; }
        const float* gain = mt < 2 ? a.p[launder_i(1)] + (size_t)l * DM : (mt == 2 ? a.p[launder_i(12)] + (size_t)l * DM : nullptr);
        cvt_item(a.p[launder_i(src)] + (size_t)l * loff, Nsrc, K, gain, mt, wset + woff, scr, r, lane);
    }
}
DI void x_row_prep4(const float* xrow, bf16* orow, float* rs, int lane) {
    const GAS f32x4* xr = (const GAS f32x4*)xrow + lane; f32x4 v[16]; float s[4] = {0.f, 0.f, 0.f, 0.f};
#pragma unroll
    for (int j = 0; j < 16; ++j) v[j] = xr[64 * j];
#pragma unroll
    for (int j = 0; j < 16; ++j) s[j >> 2] += (v[j].x * v[j].x + v[j].y * v[j].y) + (v[j].z * v[j].z + v[j].w * v[j].w);
#pragma unroll
    for (int k = 0; k < 4; ++k) s[k] = wave_sum(s[k]);
    GAS u32x2* o8 = (GAS u32x2*)orow + lane;
#pragma unroll
    for (int j = 0; j < 16; ++j) { u32x2 w; w.x = pk2(v[j].x, v[j].y); w.y = pk2(v[j].z, v[j].w); o8[64 * j] = w; }
    const float sv = (lane >> 4) == 0 ? s[0] : ((lane >> 4) == 1 ? s[1] : ((lane >> 4) == 2 ? s[2] : s[3]));
    rs[lane] = (lane & 15) == 0 ? sv : 0.f;
}
DI void transpose_task(const bf16* PR, bf16* VT, int task, int lane) {
    const int pgrp = task & 127, b = (task >> 7) & 3, vi = task >> 9;
    const int cb = vi < 4 ? (vi < 2 ? 14 + vi : 16 + vi) : 40 + vi;
    const int dsh = vi < 8 ? 0 : (vi < 12 ? 2 : 4);
    const int Lsh = 13 - dsh;
    const int dg = lane & 7, pg = lane >> 3;
    const int p0 = 64 * pgrp + 8 * pg; const int r = p0 >> Lsh, i0 = p0 & ((1 << Lsh) - 1);
    const GAS bf16* src = (const GAS bf16*)PR + ((size_t)(cb * 4 + b) * SEQ + r) * 64 + 8 * dg;
    u32x4 R[8];
#pragma unroll
    for (int k = 0; k < 8; ++k) R[k] = *(const GAS u32x4*)(src + ((size_t)(i0 + k) << dsh) * 64);
    GAS bf16* dst = (GAS bf16*)VT + ((size_t)((vi * 4 + b) * 64 + 8 * dg)) * SEQ + p0;
    GAS bf16* dstf = (GAS bf16*)VT + ((size_t)(vi * 4 + b) * 64) * SEQ + (size_t)(p0 >> 5) * 2048;
    const int pgt = (p0 >> 3) & 3, s_ = pgt >> 1, half_ = pgt & 1;
#pragma unroll
    for (int j = 0; j < 8; ++j) {
        u32x4 o;
#pragma unroll
        for (int w = 0; w < 4; ++w) o[w] = __builtin_amdgcn_perm(R[2 * w + 1][j >> 1], R[2 * w][j >> 1], (j & 1) ? 0x07060302u : 0x05040100u);
        if (vi < 4) *(GAS u32x4*)(dst + (size_t)j * SEQ) = o;
        else { const int d = 8 * dg + j, d0 = d >> 5, dd = d & 31; GAS u32x2* q = (GAS u32x2*)(dstf + (size_t)((((s_ * 2 + d0) * 2 + half_) * 32 + dd) * 2) * 4);
            u32x2 a, c2; a.x = o.x; a.y = o.y; c2.x = o.z; c2.y = o.w; q[0] = a; q[1] = c2; }
    }
}

#define MFMA32(a, b, c) __builtin_amdgcn_mfma_f32_32x32x16_bf16((a), (b), (c), 0, 0, 0)
DI int crow(int r, int hi) { return (r & 3) + 8 * (r >> 2) + 4 * hi; }
struct KFrag { bf16x8 k[4]; };
struct VFrag { u32x2 v[8]; };
DI void load_k(KFrag& K, const bf16* Kb, int kstride, int r32, int hi) {
    const GAS bf16* p = (const GAS bf16*)Kb + (size_t)r32 * kstride + 8 * hi;
#pragma unroll
    for (int d0 = 0; d0 < 4; ++d0) K.k[d0] = *(const GAS bf16x8*)(p + 16 * d0);
}
DI void load_v(VFrag& V, const bf16* Vt, int vstride, int r32, int hi) {
#pragma unroll
    for (int s = 0; s < 2; ++s)
#pragma unroll
        for (int d0 = 0; d0 < 2; ++d0) {
            const GAS bf16* vp = (const GAS bf16*)Vt + (size_t)(r32 + 32 * d0) * vstride + 16 * s + 4 * hi;
            V.v[(2 * s + d0) * 2] = *(const GAS u32x2*)vp; V.v[(2 * s + d0) * 2 + 1] = *(const GAS u32x2*)(vp + 8);
        }
}
DI void load_kf(KFrag& K, const bf16* tile, int r32, int hi) {
    const GAS bf16* p = (const GAS bf16*)tile + (size_t)(r32 * 2 + hi) * 8;
#pragma unroll
    for (int d0 = 0; d0 < 4; ++d0) K.k[d0] = *(const GAS bf16x8*)(p + d0 * 512);
}
DI void load_vf(VFrag& V, const bf16* tile, int r32, int hi) {
#pragma unroll
    for (int s = 0; s < 2; ++s)
#pragma unroll
        for (int d0 = 0; d0 < 2; ++d0) {
            const GAS u32x2* p = (const GAS u32x2*)((const GAS bf16*)tile + (size_t)((((s * 2 + d0) * 2) * 32 + r32) * 2 + hi) * 4);
            V.v[(2 * s + d0) * 2] = p[0]; V.v[(2 * s + d0) * 2 + 1] = p[64];
        }
}

DI f32x16 qk_frag(const KFrag& K, const bf16x8 (&qf)[4]) {
    f32x16 s;
#pragma unroll
    for (int i = 0; i < 16; ++i) s[i] = 0.f;
#pragma unroll
    for (int d0 = 0; d0 < 4; ++d0) s = MFMA32(K.k[d0], qf[d0], s);
    return s;
}
DI void pv_frag(const VFrag& V, const f32x16& p, f32x16& o0, f32x16& o1) {
#pragma unroll
    for (int s = 0; s < 2; ++s) {
        u32x4 pw; pw.x = pk2(p[8 * s], p[8 * s + 1]); pw.y = pk2(p[8 * s + 2], p[8 * s + 3]); pw.z = pk2(p[8 * s + 4], p[8 * s + 5]); pw.w = pk2(p[8 * s + 6], p[8 * s + 7]);
        const bf16x8 pf = __builtin_bit_cast(bf16x8, pw);
#pragma unroll
        for (int d0 = 0; d0 < 2; ++d0) {
            const u32x2 lo = V.v[(2 * s + d0) * 2], h2 = V.v[(2 * s + d0) * 2 + 1];
            u32x4 vw; vw.x = lo.x; vw.y = lo.y; vw.z = h2.x; vw.w = h2.y;
            const bf16x8 vf = __builtin_bit_cast(bf16x8, vw);
            if (d0 == 0) o0 = MFMA32(vf, pf, o0); else o1 = MFMA32(vf, pf, o1);
        }
    }
}
DI float xhalf(float v) { const auto rr = __builtin_amdgcn_permlane32_swap(__float_as_uint(v), __float_as_uint(v), false, false); return (threadIdx.x & 32) ? __uint_as_float(rr[0]) : __uint_as_float(rr[1]); }
DI float xhalf_max(float v) { const auto rr = __builtin_amdgcn_permlane32_swap(__float_as_uint(v), __float_as_uint(v), false, false); return fmaxf(__uint_as_float(rr[0]), __uint_as_float(rr[1])); }
DI float xhalf_sum(float v) { const auto rr = __builtin_amdgcn_permlane32_swap(__float_as_uint(v), __float_as_uint(v), false, false); return __uint_as_float(rr[0]) + __uint_as_float(rr[1]); }
struct Flash { f32x16 o0, o1; float m, l; };
DI void flash_init(Flash& f) {
#pragma unroll
    for (int i = 0; i < 16; ++i) { f.o0[i] = 0.f; f.o1[i] = 0.f; }
    f.m = -1e20f; f.l = 0.f; }
DI void flash_step(Flash& f, f32x16& sc, const VFrag& V) {
    float mx = sc[0];
#pragma unroll
    for (int r = 1; r < 16; ++r) mx = fmaxf(mx, sc[r]);
    mx = xhalf_max(mx);
    const float mn = fmaxf(f.m, mx); const float alpha = fast_exp2(f.m - mn); f.m = mn;
    float ls = 0.f;
#pragma unroll
    for (int r = 0; r < 16; ++r) { sc[r] = fast_exp2(sc[r] - mn); ls += sc[r]; }
    f.l = f.l * alpha + ls;
    if (__builtin_amdgcn_ballot_w64(alpha != 1.f)) {
#pragma unroll
        for (int r = 0; r < 16; ++r) { f.o0[r] *= alpha; f.o1[r] *= alpha; }
    }
    pv_frag(V, sc, f.o0, f.o1);
}
constexpr int IMP_PITCH = 129;
constexpr int KB_BYTES = 64 * 144, VB_BYTES = 64 * 136, TBUF = KB_BYTES + VB_BYTES;
constexpr int LDS_SELM = 4 * 64 * IMP_PITCH * 4;
constexpr int LDS_INVL = LDS_SELM + 1024, LDS_CBUF = LDS_INVL + 1024, LDS_TB = 0;
static_assert(LDS_CBUF % 16 == 0 && TBUF % 16 == 0 && LDS_CBUF + TBUF <= LDS_BYTES - 64 && 2 * TBUF <= LDS_SELM, "attention LDS map");
struct StageRegs { u32x4 k, v; };
DI void stage_load(StageRegs& R, const bf16* Kb, int kstride, const bf16* Vt, int vstride, int tid, bool withV) {
    const int rw = tid >> 3, ch = tid & 7;
    R.k = *(const GAS u32x4*)((const GAS bf16*)Kb + (size_t)rw * kstride + ch * 8);
    if (withV) R.v = *(const GAS u32x4*)((const GAS bf16*)Vt + (size_t)rw * vstride + ch * 8);
}
DI void stage_store(LAS unsigned char* buf, const StageRegs& R, int tid, bool withV) {
    const int rw = tid >> 3, ch = tid & 7;
    *(LAS u32x4*)(buf + rw * 144 + ch * 16) = R.k;
    if (withV) { LAS u32x2* p = (LAS u32x2*)(buf + KB_BYTES + rw * 136 + ch * 16); u32x2 a, b2; a.x = R.v.x; a.y = R.v.y; b2.x = R.v.z; b2.y = R.v.w; p[0] = a; p[1] = b2; }
}
DI void lds_k(KFrag& K, const LAS unsigned char* buf, int sub, int r32, int hi) {
    const LAS unsigned char* p = buf + (32 * sub + r32) * 144 + 16 * hi;
#pragma unroll
    for (int d0 = 0; d0 < 4; ++d0) K.k[d0] = *(const LAS bf16x8*)(p + 32 * d0);
}
DI void lds_v(VFrag& V, const LAS unsigned char* buf, int sub, int r32, int hi) {
#pragma unroll
    for (int s = 0; s < 2; ++s)
#pragma unroll
        for (int d0 = 0; d0 < 2; ++d0) {
            const LAS unsigned char* p = buf + KB_BYTES + (r32 + 32 * d0) * 136 + (32 * sub + 16 * s + 4 * hi) * 2;
            V.v[(2 * s + d0) * 2] = *(const LAS u32x2*)p; V.v[(2 * s + d0) * 2 + 1] = *(const LAS u32x2*)(p + 16);
        }
}

struct Soft { f32x16 o0, o1; float mref, l; bool seen; };
DI void soft_init(Soft& f) {
#pragma unroll
    for (int i = 0; i < 16; ++i) { f.o0[i] = 0.f; f.o1[i] = 0.f; }
    f.mref = 0.f; f.l = 0.f; f.seen = false; }
DI int ccol(int r) { return (r & 3) + 8 * (r >> 2); }
DI void tile_scores(f32x16& x0, f32x16& x1, const LAS unsigned char* buf, const bf16x8 (&qf)[4], float sk, float aref, int p0, bool laneok, bool needmask, int lo, int hip, int r32, int hi) {
    KFrag K0, K1; lds_k(K0, buf, 0, r32, hi); lds_k(K1, buf, 1, r32, hi);
    const float B = laneok ? fmaf(sk, (float)(p0 + 4 * hi), -aref) : -1e30f;
    const float B1 = B + 32.f * sk;
#pragma unroll
    for (int r = 0; r < 16; ++r) { x0[r] = fmaf(sk, (float)ccol(r), B); x1[r] = fmaf(sk, (float)ccol(r), B1); }
#pragma unroll
    for (int d0 = 0; d0 < 4; ++d0) { x0 = MFMA32(K0.k[d0], qf[d0], x0); x1 = MFMA32(K1.k[d0], qf[d0], x1); }
    if (needmask) {
#pragma unroll
        for (int r = 0; r < 16; ++r) { const int pos = p0 + crow(r, hi); if (pos < lo || pos > hip) x0[r] = -1e30f; if (pos + 32 < lo || pos + 32 > hip) x1[r] = -1e30f; }
    }
}
DI float soft_update(Soft& f, f32x16& x0, f32x16& x1, bool hasO) {
    float ma = fmaxf(fmaxf(x0[0], x1[0]), x0[1]), mb = fmaxf(fmaxf(x1[1], x0[2]), x1[2]);
#pragma unroll
    for (int r = 3; r < 15; r += 2) { ma = fmaxf(fmaxf(ma, x0[r]), x1[r]); mb = fmaxf(fmaxf(mb, x0[r + 1]), x1[r + 1]); }
    ma = fmaxf(fmaxf(ma, x0[15]), x1[15]);
    float mx = xhalf_max(fmaxf(ma, mb));
    const bool valid = mx > -1e20f;
    const bool need = valid && (mx > 8.f || !f.seen);
    float dmove = 0.f;
    if (__builtin_amdgcn_ballot_w64(need)) {
        const float delta = need ? fmaxf(mx, -60.f) : 0.f; const float sc = fast_exp2(-delta);
        dmove = delta;
        f.mref += delta; f.l *= sc;
        if (hasO) {
#pragma unroll
            for (int r = 0; r < 16; ++r) { f.o0[r] *= sc; f.o1[r] *= sc; } }
#pragma unroll
        for (int r = 0; r < 16; ++r) { x0[r] -= delta; x1[r] -= delta; }
    }
    f.seen = f.seen || valid;
    float ls = 0.f;
#pragma unroll
    for (int r = 0; r < 16; ++r) { x0[r] = fast_exp2(x0[r]); x1[r] = fast_exp2(x1[r]); ls += x0[r] + x1[r]; }
    f.l += ls;
    return dmove;
}
DI void tile_pv(Soft& f, const LAS unsigned char* buf, const f32x16& p0v, const f32x16& p1v, int r32, int hi) {
    VFrag V0, V1; lds_v(V0, buf, 0, r32, hi); lds_v(V1, buf, 1, r32, hi);
    pv_frag(V0, p0v, f.o0, f.o1); pv_frag(V1, p1v, f.o0, f.o1);
}
DI void tile_pv2(Soft& f, const VFrag& V0, const VFrag& V1, const f32x16& p0v, const f32x16& p1v) { pv_frag(V0, p0v, f.o0, f.o1); pv_frag(V1, p1v, f.o0, f.o1); }

DI void frag_scores(f32x16& x0, const KFrag& K0, const bf16x8 (&qf)[4], float sk, float aref, int p0, bool needmask, int lo, int hip, int hi) {
    const float B = fmaf(sk, (float)(p0 + 4 * hi), -aref);
#pragma unroll
    for (int r = 0; r < 16; ++r) x0[r] = fmaf(sk, (float)ccol(r), B);
#pragma unroll
    for (int d0 = 0; d0 < 4; ++d0) x0 = MFMA32(K0.k[d0], qf[d0], x0);
    if (needmask) {
#pragma unroll
        for (int r = 0; r < 16; ++r) { const int pos = p0 + crow(r, hi); if (pos < lo || pos > hip) x0[r] = -1e30f; }
    }
}
DI void soft_update1(Soft& f, f32x16& x0) {
    float mx = x0[0];
#pragma unroll
    for (int r = 1; r < 16; ++r) mx = fmaxf(mx, x0[r]);
    mx = xhalf_max(mx);
    const bool valid = mx > -1e20f;
    const bool need = valid && (mx > 8.f || !f.seen);
    if (__builtin_amdgcn_ballot_w64(need)) {
        const float delta = need ? fmaxf(mx, -60.f) : 0.f; const float sc = fast_exp2(-delta);
        f.mref += delta; f.l *= sc;
#pragma unroll
        for (int r = 0; r < 16; ++r) { f.o0[r] *= sc; f.o1[r] *= sc; x0[r] -= delta; }
    }
    f.seen = f.seen || valid;
    float ls = 0.f;
#pragma unroll
    for (int r = 0; r < 16; ++r) { x0[r] = fast_exp2(x0[r]); ls += x0[r]; }
    f.l += ls;
}

DI void nsa_unit(const bf16* PR, const bf16* VT, const bf16* kcb, const bf16* vctb, bf16* Y, LAS unsigned char* lds, int b, int g, int jt) {
    const int tid = pg8::pg8_tid(), lane = tid & 63, r32 = lane & 31, hi = lane >> 5, wid = __builtin_amdgcn_readfirstlane(tid >> 6);
    const int hq = wid & 3, th = wid >> 2, h = 4 * g + hq;
    const int tl = 32 * th + r32, t = 64 * jt + tl; const size_t row = (size_t)b * SEQ + t;
    const int tw0 = 64 * jt + 32 * th;
    const float slope2 = exp2f(-0.4f * (float)(9 + h)) * LOG2E;
    bf16x8 qf[4];
    { const GAS bf16* qp = (const GAS bf16*)PR + ((size_t)h * NTOK + row) * 64 + 8 * hi;
#pragma unroll
      for (int d0 = 0; d0 < 4; ++d0) qf[d0] = *(const GAS bf16x8*)(qp + 16 * d0); }
    float g0, g1, g2;
    { const GAS bf16* gp = (const GAS bf16*)PR + ((size_t)56 * NTOK + row) * 64 + h * 3; g0 = bf2f(gp[0]); g1 = bf2f(gp[1]); g2 = bf2f(gp[2]); }
    LAS float* imp = (LAS float*)lds; LAS unsigned* selm = (LAS unsigned*)(lds + LDS_SELM); LAS float* invl = (LAS float*)(lds + LDS_INVL); LAS unsigned char* tb = lds + LDS_TB;
    { LAS float* zr = imp + (size_t)(tid >> 1) * IMP_PITCH;
      for (int j = tid & 1; j <= jt; j += 2) zr[j] = 0.f; }
    f32x16 acc0, acc1;
    StageRegs R;
    {
        const bf16* kc = kcb + (size_t)(g * 4 + b) * 512 * 64; const bf16* vct = vctb + (size_t)(g * 4 + b) * 64 * 512;
        const int nq = (t >= 31) ? ((t - 31) >> 4) : -1;
        const int nhi_w = 4 * jt + 2 * th;
        const int nqmin = (tw0 >= 31) ? ((tw0 - 31) >> 4) : -1;
        const int ncmp = ((4 * jt + 2) >> 6) + 1;
        const float sk = 16.f * slope2, ab = slope2 * (float)(t - 31);
        Soft f; soft_init(f);
        LAS unsigned char* cbuf = lds + LDS_CBUF;
        LAS float* impw = imp + ((size_t)hq * 64 + tl) * IMP_PITCH;
        stage_load(R, kc + (size_t)(ncmp - 1) * 64 * 64, 64, vct + 64 * (ncmp - 1), 512, tid, true); stage_store(cbuf, R, tid, true); __syncthreads();
        for (int i = ncmp - 1; i >= 0; --i) {
            if (i > 0) stage_load(R, kc + (size_t)(i - 1) * 64 * 64, 64, vct + 64 * (i - 1), 512, tid, true);
            if (64 * i <= nhi_w) {
                VFrag V0, V1; lds_v(V0, cbuf, 0, r32, hi); lds_v(V1, cbuf, 1, r32, hi);
                f32x16 x0, x1; tile_scores(x0, x1, cbuf, qf, sk, ab + f.mref, 64 * i, true, 64 * i + 63 > nqmin, -(1 << 30), nq, r32, hi);
                const bool had = f.seen;
                const float dl = soft_update(f, x0, x1, true);
                if (__builtin_amdgcn_ballot_w64(had && dl != 0.f)) {
                    const float sc = (had && dl != 0.f) ? fast_exp2(-dl) : 1.f;
                    for (int j = hi; j < 128; j += 2) impw[j] *= sc;
                }
#pragma unroll
                for (int a = 0; a < 4; ++a) { const int j = 16 * i + 2 * a + hi; const float h3 = 0.5f * x0[4 * a + 3], h3b = 0.5f * x1[4 * a + 3];
                    __hip_atomic_fetch_add(impw + j, (x0[4 * a] + x0[4 * a + 1]) + (x0[4 * a + 2] + h3), __ATOMIC_RELAXED, __HIP_MEMORY_SCOPE_WORKGROUP);
                    __hip_atomic_fetch_add(impw + j + 1, h3, __ATOMIC_RELAXED, __HIP_MEMORY_SCOPE_WORKGROUP);
                    __hip_atomic_fetch_add(impw + j + 8, (x1[4 * a] + x1[4 * a + 1]) + (x1[4 * a + 2] + h3b), __ATOMIC_RELAXED, __HIP_MEMORY_SCOPE_WORKGROUP);
                    if (j + 9 <= 127) __hip_atomic_fetch_add(impw + j + 9, h3b, __ATOMIC_RELAXED, __HIP_MEMORY_SCOPE_WORKGROUP); }
                tile_pv2(f, V0, V1, x0, x1);
            }
            __syncthreads();
            if (i > 0) { stage_store(cbuf, R, tid, true); __syncthreads(); }
        }
        const float l = xhalf_sum(f.l);
        const float inv_l = l > 0.f ? 1.f / l : 0.f;
        if (hi == 0) invl[hq * 64 + tl] = inv_l;
        const float gs = g0 * inv_l;
#pragma unroll
        for (int i = 0; i < 16; ++i) { acc0[i] = gs * f.o0[i]; acc1[i] = gs * f.o1[i]; }
    }
    __syncthreads();
    {
        const int tok = 8 * wid + (lane >> 3), sub = lane & 7;
        float v[16]; unsigned selbits = 0u;
#pragma unroll
        for (int k = 0; k < 16; ++k) { const int j = 16 * sub + k;
            const bool valid = j <= jt, forced = (j == 0) || (j == jt) || (j == jt - 1);
            float s = -1.f;
            if (valid && !forced) s = (imp[((size_t)0 * 64 + tok) * IMP_PITCH + j] * invl[0 * 64 + tok] + imp[((size_t)1 * 64 + tok) * IMP_PITCH + j] * invl[1 * 64 + tok])
                                    + (imp[((size_t)2 * 64 + tok) * IMP_PITCH + j] * invl[2 * 64 + tok] + imp[((size_t)3 * 64 + tok) * IMP_PITCH + j] * invl[3 * 64 + tok]);
            if (valid && (forced || jt < 16)) selbits |= 1u << k;
            v[k] = s; }
        if (jt >= 16) {
            for (int round = 0; round < 13; ++round) {
                float bv = -1.f; int bj = 1 << 20;
#pragma unroll
                for (int k = 0; k < 16; ++k) { if (v[k] > bv) { bv = v[k]; bj = 16 * sub + k; } }
#define SEL_DPP_STEP(ctrl_) do { const float ov = __uint_as_float((unsigned)__builtin_amdgcn_mov_dpp((int)__float_as_uint(bv), ctrl_, 0xf, 0xf, true)); const int oj = __builtin_amdgcn_mov_dpp(bj, ctrl_, 0xf, 0xf, true); \
                    if (ov > bv || (ov == bv && oj < bj)) { bv = ov; bj = oj; } } while (0)
                SEL_DPP_STEP(0xB1); SEL_DPP_STEP(0x4E); SEL_DPP_STEP(0x141);
#undef SEL_DPP_STEP
                if ((bj >> 4) == sub) {
#pragma unroll
                    for (int k = 0; k < 16; ++k) if (k == (bj & 15)) { v[k] = -1.f; selbits |= 1u << k; }
                }
            }
        }
        ((LAS unsigned short*)selm)[tok * 8 + sub] = (unsigned short)selbits;
    }
    __syncthreads();
    {
        unsigned mk0, mk1, mk2, mk3, wu0, wu1, wu2, wu3, gu0, gu1, gu2, gu3;
        { unsigned mk[4], wu[4], gu[4];
#pragma unroll
          for (int w = 0; w < 4; ++w) { mk[w] = selm[tl * 4 + w]; unsigned u = mk[w];
#pragma unroll
              for (int off = 1; off < 32; off <<= 1) u |= (unsigned)__shfl_xor((int)u, off);
              wu[w] = __builtin_amdgcn_readfirstlane(u);
              unsigned u2 = selm[lane * 4 + w];
#pragma unroll
              for (int off = 1; off < 64; off <<= 1) u2 |= (unsigned)__shfl_xor((int)u2, off);
              gu[w] = __builtin_amdgcn_readfirstlane(u2); }
          mk0 = mk[0]; mk1 = mk[1]; mk2 = mk[2]; mk3 = mk[3]; wu0 = wu[0]; wu1 = wu[1]; wu2 = wu[2]; wu3 = wu[3]; gu0 = gu[0]; gu1 = gu[1]; gu2 = gu[2]; gu3 = gu[3]; }
        Soft f; soft_init(f);
        const bf16* ks = PR + ((size_t)(12 + g) * NTOK + (size_t)b * SEQ) * 64; const bf16* vst = VT + ((size_t)(g * 4 + b) * 64) * SEQ;
        const float ab = slope2 * (float)t;
        int itw = 3; unsigned itbits = gu3;
#define SEL_NEXT(j_) do { j_ = -1; while (itbits == 0u && itw > 0) { --itw; itbits = itw == 2 ? gu2 : (itw == 1 ? gu1 : gu0); } \
            if (itbits != 0u) { const int jb_ = 31 - __builtin_clz(itbits); itbits &= ~(1u << jb_); j_ = 32 * itw + jb_; } } while (0)
        int jcur; SEL_NEXT(jcur);
        stage_load(R, ks + (size_t)jcur * 64 * 64, 64, vst + 64 * jcur, SEQ, tid, true); stage_store(tb, R, tid, true); __syncthreads();
        int par = 0;
        while (jcur >= 0) {
            int jnext; SEL_NEXT(jnext);
            if (jnext >= 0) stage_load(R, ks + (size_t)jnext * 64 * 64, 64, vst + 64 * jnext, SEQ, tid, true);
            const LAS unsigned char* buf = tb + par * TBUF;
            const int jw = jcur >> 5, jb = jcur & 31;
            const unsigned wuw = jw == 0 ? wu0 : (jw == 1 ? wu1 : (jw == 2 ? wu2 : wu3));
            if ((wuw >> jb) & 1u) {
                const unsigned mw = jw == 0 ? mk0 : (jw == 1 ? mk1 : (jw == 2 ? mk2 : mk3));
                const bool mysel = (mw >> jb) & 1u;
                VFrag V0, V1; lds_v(V0, buf, 0, r32, hi); lds_v(V1, buf, 1, r32, hi);
                f32x16 x0, x1; tile_scores(x0, x1, buf, qf, slope2, ab + f.mref, 64 * jcur, mysel, jcur == jt, -(1 << 30), t, r32, hi);
                soft_update(f, x0, x1, true);
                tile_pv2(f, V0, V1, x0, x1);
            }
            if (jnext >= 0) stage_store(tb + (par ^ 1) * TBUF, R, tid, true);
            __syncthreads();
            par ^= 1; jcur = jnext;
        }
#undef SEL_NEXT
        const float l = xhalf_sum(f.l); const float sc_ = l > 0.f ? g1 / l : 0.f;
#pragma unroll
        for (int i = 0; i < 16; ++i) { acc0[i] += sc_ * f.o0[i]; acc1[i] += sc_ * f.o1[i]; }
    }
    {
        Soft f; soft_init(f);
        const bf16* kw = PR + ((size_t)(16 + g) * NTOK + (size_t)b * SEQ) * 64; const bf16* vwt = VT + ((size_t)((2 + g) * 4 + b) * 64) * SEQ;
        const float ab = slope2 * (float)t;
        const int kfirst = jt >= 8 ? 64 * (jt - 8) : 0, klast = 64 * jt;
        stage_load(R, kw + (size_t)klast * 64, 64, vwt + klast, SEQ, tid, true); stage_store(tb, R, tid, true); __syncthreads();
        int par = 0;
        for (int kt = klast; kt >= kfirst; kt -= 64) {
            if (kt - 64 >= kfirst) stage_load(R, kw + (size_t)(kt - 64) * 64, 64, vwt + kt - 64, SEQ, tid, true);
            const LAS unsigned char* buf = tb + par * TBUF;
            if (kt + 63 >= tw0 - 511) {
                const bool needmask = (kt + 63 > tw0) || (kt < tw0 + 31 - 511);
                VFrag V0, V1; lds_v(V0, buf, 0, r32, hi); lds_v(V1, buf, 1, r32, hi);
                f32x16 x0, x1; tile_scores(x0, x1, buf, qf, slope2, ab + f.mref, kt, true, needmask, t - 511, t, r32, hi);
                soft_update(f, x0, x1, true);
                tile_pv2(f, V0, V1, x0, x1);
            }
            if (kt - 64 >= kfirst) stage_store(tb + (par ^ 1) * TBUF, R, tid, true);
            __syncthreads();
            par ^= 1;
        }
        const float l = xhalf_sum(f.l); const float sc_ = l > 0.f ? g2 / l : 0.f;
#pragma unroll
        for (int i = 0; i < 16; ++i) { acc0[i] += sc_ * f.o0[i]; acc1[i] += sc_ * f.o1[i]; }
    }
    { GAS bf16* yp = (GAS bf16*)Y + row * 768 + h * 64 + 4 * hi;
#pragma unroll
      for (int a = 0; a < 4; ++a) {
          u32x2 w0; w0.x = pk2(acc0[4 * a], acc0[4 * a + 1]); w0.y = pk2(acc0[4 * a + 2], acc0[4 * a + 3]); *(GAS u32x2*)(yp + 8 * a) = w0;
          u32x2 w1; w1.x = pk2(acc1[4 * a], acc1[4 * a + 1]); w1.y = pk2(acc1[4 * a + 2], acc1[4 * a + 3]); *(GAS u32x2*)(yp + 32 + 8 * a) = w1; } }
}

constexpr int DIL_YOFF = 4096, DIL_YPITCH = 136;
static_assert(DIL_YOFF + 512 * DIL_YPITCH <= LDS_BYTES - 64, "dilated-unit LDS map");
DI void dil_unit(const bf16* PR, const bf16* VT, bf16* Y, LAS unsigned char* lds, int b, int hh, int tb) {
    const int tid = pg8::pg8_tid(), lane = tid & 63, r32 = lane & 31, hi = lane >> 5, wid = __builtin_amdgcn_readfirstlane(tid >> 6);
    LAS float* lser = (LAS float*)lds; LAS unsigned char* yl = lds + DIL_YOFF;
    for (int gidx = 0; gidx < 3; ++gidx) {
        const int dsh = 2 * gidx, dil = 1 << dsh, nsub = 16 >> dsh, L = SEQ >> dsh;
        const int kidx = gidx < 2 ? 1 + 4 * gidx + hh : 17 + hh;
        const float slope2d = exp2f(-0.4f * (float)kidx) * LOG2E * (float)dil;
        for (int wt = wid; wt < 16; wt += 8) {
            const int r = wt / nsub, sb = wt - r * nsub; const int i0 = ((512 * tb) >> dsh) + 32 * sb; const int i = i0 + r32; const int t = r + (i << dsh);
            const size_t row = (size_t)b * SEQ + t;
            bf16x8 qf[4];
            { const GAS bf16* qp = (const GAS bf16*)PR + ((size_t)(20 + gidx * 4 + hh) * NTOK + row) * 64 + 8 * hi;
#pragma unroll
              for (int d0 = 0; d0 < 4; ++d0) qf[d0] = *(const GAS bf16x8*)(qp + 16 * d0); }
            const bf16* kpl = PR + ((size_t)(32 + gidx * 4 + hh) * NTOK + (size_t)b * SEQ) * 64;
            const bf16* vpl = VT + ((size_t)(((4 + gidx * 4 + hh) * 4 + b) * 64)) * SEQ; const int pr = r * L;
            Soft f; soft_init(f);
            const int ipf = i0 - 128 < 0 ? 0 : i0 - 128;
            const float ab = slope2d * (float)i;
            KFrag Kq[3]; VFrag Vq[3];
#define DIL_LOAD(slot, s_) do { const int ip_ = i0 - 32 * (s_) >= ipf ? i0 - 32 * (s_) : ipf; const size_t to_ = (size_t)((pr + ip_) >> 5) * 2048; load_kf(Kq[slot], kpl + to_, r32, hi); load_vf(Vq[slot], vpl + to_, r32, hi); } while (0)
            DIL_LOAD(0, 0); DIL_LOAD(1, 1);
#pragma unroll
            for (int s = 0; s < 5; ++s) {
                if (s + 2 < 5) DIL_LOAD((s + 2) % 3, s + 2);
                const int ip0 = i0 - 32 * s;
                if (ip0 >= ipf) {
                    f32x16 x; frag_scores(x, Kq[s % 3], qf, slope2d, ab + f.mref, ip0, s == 0 || s == 4, i - 128, i, hi);
                    soft_update1(f, x);
                    pv_frag(Vq[s % 3], x, f.o0, f.o1);
                }
            }
#undef DIL_LOAD
            const float l = xhalf_sum(f.l); const float inv = 1.f / l; const float lse2 = f.mref + __builtin_amdgcn_logf(l);
            const int tloc = t - 512 * tb;
            LAS unsigned char* yp = yl + tloc * DIL_YPITCH + 8 * hi;
            float wa = 0.f, wb = inv, lnew = lse2;
            if (gidx > 0) { const float Lr = lser[tloc]; const float M = fmaxf(Lr, lse2); const float ea = fast_exp2(Lr - M), eb = fast_exp2(lse2 - M); const float den = 1.f / (ea + eb);
                wa = ea * den; wb = eb * den * inv; lnew = M + __builtin_amdgcn_logf(ea + eb); }
#pragma unroll
            for (int a = 0; a < 4; ++a)
#pragma unroll
                for (int d0 = 0; d0 < 2; ++d0) {
                    LAS u32x2* p = (LAS u32x2*)(yp + 64 * d0 + 16 * a);
                    float o[4];
#pragma unroll
                    for (int k = 0; k < 4; ++k) o[k] = wb * (d0 ? f.o1[4 * a + k] : f.o0[4 * a + k]);
                    if (gidx > 0) { const u32x2 y = *p; o[0] += wa * __uint_as_float(y.x << 16); o[1] += wa * __uint_as_float(y.x & 0xffff0000u); o[2] += wa * __uint_as_float(y.y << 16); o[3] += wa * __uint_as_float(y.y & 0xffff0000u); }
                    u32x2 w; w.x = pk2(o[0], o[1]); w.y = pk2(o[2], o[3]); *p = w;
                }
            if (hi == 0) lser[tloc] = lnew;
        }
        __syncthreads();
    }
    { const size_t rowb = (size_t)b * SEQ + 512 * tb;
#pragma unroll
      for (int k = 0; k < 8; ++k) { const int tok = (tid >> 3) + 64 * k, ch = tid & 7;
          const LAS u32x2* p = (const LAS u32x2*)(yl + tok * DIL_YPITCH + ch * 16); const u32x2 a = p[0], c2 = p[1];
          u32x4 w; w.x = a.x; w.y = a.y; w.z = c2.x; w.w = c2.y;
          *(GAS u32x4*)((GAS bf16*)Y + (rowb + tok) * 768 + 512 + hh * 64 + ch * 8) = w; } }
    __syncthreads();
}
#ifndef REP_PRO
#define REP_PRO 1
#endif
constexpr int CVT_SPLIT = 5120;
#ifndef REP_P1
#define REP_P1 1
#endif
#ifndef REP_P2
#define REP_P2 1
#endif
#ifndef REP_P3
#define REP_P3 1
#endif
#ifndef REP_P4
#define REP_P4 1
#endif
#ifndef REP_P6
#define REP_P6 1
#endif
#ifndef REP_SYNC
#define REP_SYNC 0
#endif
#ifndef REP_NSA
#define REP_NSA 1
#endif
#ifndef REP_DIL
#define REP_DIL 1
#endif
#define GEMM_PHASE(EpiT, SchedT, g, S, E) pg8::gemm_phase<EpiT, SchedT, true, true>(ldsl, g, S, E)
#define PHASE_HEAD const int G = launder_i((int)gridDim.x), c = launder_i((int)blockIdx.x); unsigned char* ws = (unsigned char*)a.p[launder_i(17)]; (void)G; (void)c; \
    const int tid = pg8::pg8_tid(), lane = tid & 63, wid = __builtin_amdgcn_readfirstlane(tid >> 6); (void)lane; (void)wid; \
    bf16* wset = (bf16*)(ws + ((l & 1) ? WS_W1 : WS_W0)); (void)wset; float* rsum = (float*)(ws + WS_RSUM); (void)rsum; bf16* xb = (bf16*)(ws + WS_XB); (void)xb; bf16* PR = (bf16*)(ws + WS_PR); (void)PR;

DI void phase_prologue(const Args& a, LAS unsigned char* ldsl) { const int l = 0; PHASE_HEAD
    const int gw = c * 8 + wid, NGW = G * 8; float* bias1 = (float*)(ws + WS_BIAS);
    LAS float* scr = (LAS float*)(ldsl + wid * 16384);
    convert_layer(a, 0, (bf16*)(ws + WS_W0), scr, gw, NGW, lane, 1920);
    convert_layer(a, 0, (bf16*)(ws + WS_W0), scr, 8064 + gw, NGW, lane, CVT_ITEMS);
    for (int row = 4 * gw; row < NTOK; row += 4 * NGW) x_row_prep4(a.p[launder_i(0)] + (size_t)row * DM, xb + (size_t)row * DM, rsum + (size_t)row * 16, lane);
    for (int task = gw; task < DEPTH * 2 * 256; task += NGW) {
        const int col = task & 255, kv = (task >> 8) & 1, ll = task >> 9;
        const float* pe = a.p[launder_i(kv ? 4 : 3)] + (size_t)ll * 2048; const float* w1 = a.p[launder_i(kv ? 7 : 5)] + (size_t)ll * 2048 * 256;
        float s = 0.f; float wv[32];
#pragma unroll
        for (int i = 0; i < 32; ++i) wv[i] = w1[(size_t)(lane + 64 * i) * 256 + col];
#pragma unroll
        for (int i = 0; i < 32; ++i) s += pe[lane + 64 * i] * wv[i];
        s = wave_sum(s);
        if (lane == 0) bias1[task] = s;
    }
}
DI void phase_inproj(const Args& a, LAS unsigned char* ldsl, int l) { PHASE_HEAD
    Gemm g{xb, wset + W_IN, NTOK, 3584, 1024, 1024, 1024}; pg8::StaticOrder S; S.init(NTOK, 3584, G, c); EpiProj E{PR, rsum, (LAS float*)(ldsl + 131072)};
    GEMM_PHASE(EpiProj, pg8::StaticOrder, g, S, E); }
DI void phase_compress_a(const Args& a, LAS unsigned char* ldsl, int l) { PHASE_HEAD
    bf16* VT = (bf16*)(ws + WS_VT); float* part = (float*)(ws + WS_PART);
    if (c < 64) {
        const int kv = c >> 5, kh = (c >> 4) & 1, pm = c & 15;
        Gemm g{PR + (size_t)(8 + 2 * kv) * NTOK * 64 + kh * 1024, wset + (kv ? W_CV1 : W_CK1) + kh * 1024, 4096, 256, 1024, 1024, 2048}; OneUnit S{pm, 0, 1};
        EpiF32 E{part + (size_t)(kv * 2 + kh) * 4096 * 256, 256};
        GEMM_PHASE(EpiF32, OneUnit, g, S, E);
    } else {
        { Gemm g{xb, wset + W_IN + (size_t)3584 * 1024, NTOK, 256, 1024, 1024, 1024}; OneUnit S{c - 64, 0, (c - 64) < NTOK / 256 ? 1 : 0}; EpiGa E{PR, rsum};
          GEMM_PHASE(EpiGa, OneUnit, g, S, E); }
        if (c >= 192) { for (int task = (c - 192) * 8 + wid; task < 5888; task += 64 * 8) transpose_task(PR, VT, task, lane); }
        else { for (int task = 5888 + (c - 64) * 8 + wid; task < 16 * 4 * 128; task += 128 * 8) transpose_task(PR, VT, task, lane); }
    } }
DI void phase_attn(const Args& a, LAS unsigned char* ldsl, int l) { PHASE_HEAD
    float* bias1 = (float*)(ws + WS_BIAS); bf16* kcb = (bf16*)(ws + WS_KC); bf16* vctb = (bf16*)(ws + WS_VCT); bf16* Hb = (bf16*)(ws + WS_H); const float* part = (const float*)(ws + WS_PART);
    bf16* VT = (bf16*)(ws + WS_VT); bf16* Y = (bf16*)(ws + WS_Y);
    unsigned* flag = (unsigned*)ws + XCD_BAR_WORDS + 64 * (32 + l);
    if (c < 32) {
        const int kv = c >> 4, pm = c & 15;
        { const GAS f32x4* p0 = (const GAS f32x4*)(part + (size_t)(kv * 2) * 4096 * 256 + (size_t)pm * 256 * 256); const GAS f32x4* p1 = p0 + (size_t)4096 * 256 / 4;
          const GAS f32x4* bs = (const GAS f32x4*)(bias1 + (size_t)(l * 2 + kv) * 256); GAS u32x2* ho = (GAS u32x2*)(Hb + (size_t)kv * 4096 * 256 + (size_t)pm * 256 * 256);
          const f32x4 bv = bs[tid & 63];
          for (int i0 = tid; i0 < 256 * 256 / 4; i0 += 512 * 8) {
              f32x4 va[8], vb[8];
#pragma unroll
              for (int k = 0; k < 8; ++k) { va[k] = p0[i0 + 512 * k]; vb[k] = p1[i0 + 512 * k]; }
#pragma unroll
              for (int k = 0; k < 8; ++k) { const f32x4 v = va[k] + vb[k] + bv;
                  u32x2 w; w.x = pk2(siluf_(v[0]), siluf_(v[1])); w.y = pk2(siluf_(v[2]), siluf_(v[3])); ho[i0 + 512 * k] = w; } } }
        __builtin_amdgcn_fence(__ATOMIC_RELEASE, "workgroup"); __syncthreads(); __builtin_amdgcn_fence(__ATOMIC_ACQUIRE, "workgroup");
        { Gemm g{Hb + (size_t)kv * 4096 * 256, wset + (kv ? W_CV2 : W_CK2), 4096, 256, 256, 256, 256}; OneUnit S{pm, 0, 1};
          EpiCmp E{kv ? vctb : kcb, kv};
          GEMM_PHASE(EpiCmp, OneUnit, g, S, E); }
        asm volatile("s_waitcnt vmcnt(0)" ::: "memory");
        __syncthreads();
        if (tid == 0) { __builtin_amdgcn_fence(__ATOMIC_RELEASE, "agent"); asm volatile("s_waitcnt vmcnt(0)" ::: "memory");
            (void)__hip_atomic_fetch_add(flag, 1u, __ATOMIC_RELAXED, __HIP_MEMORY_SCOPE_AGENT); }
    }
    const int xq = c & 7;
    unsigned* ctr = (unsigned*)ws + XCD_BAR_WORDS + 64 * (8 * l + xq);
    volatile LAS int* qslot = (volatile LAS int*)(ldsl + LDS_BYTES - 32);
    const int nitems = 160 + ((l + 1 < DEPTH) ? 16 : 0) + (l == 0 ? 16 : 0);
    bool kc_ready = false;
    for (;;) {
        if (tid == 0) *qslot = (int)__hip_atomic_fetch_add(ctr, 1u, __ATOMIC_RELAXED, __HIP_MEMORY_SCOPE_AGENT);
        __syncthreads();
        const int q = __builtin_amdgcn_readfirstlane(*qslot);
        __syncthreads();
        if (q >= nitems) break;
        if (q < 32) { const int pl = 2 * xq + (q >> 4); dil_unit(PR, VT, Y, ldsl, pl >> 2, pl & 3, q & 15); }
        else if (q < 160) {
            if (!kc_ready) {
                if (tid == 0) { unsigned sp = 0u;
                    while (__hip_atomic_load(flag, __ATOMIC_RELAXED, __HIP_MEMORY_SCOPE_AGENT) < 32u) { __builtin_amdgcn_s_sleep(1); if (++sp > (1u << 24)) break; }
                    __builtin_amdgcn_fence(__ATOMIC_ACQUIRE, "agent"); asm volatile("s_waitcnt vmcnt(0)" ::: "memory"); }
                __syncthreads();
                kc_ready = true;
            }
            nsa_unit(PR, VT, kcb, vctb, Y, ldsl, xq >> 1, xq & 1, 159 - q);
        } else if (l == 0 && q >= 176) {
            const int gch = xq * 16 + (q - 176); const int i0 = 1920 + gch * 48, i1 = i0 + 48 < 8064 ? i0 + 48 : 8064;
            LAS float* scr = (LAS float*)(ldsl + wid * 16384);
            convert_layer(a, 0, (bf16*)(ws + WS_W0), scr, i0 + wid, 8, lane, i1);
            __syncthreads();
        } else {
            const int gch = xq * 16 + (q - 160); const int i0 = gch * 68, i1 = i0 + 68 < CVT_ITEMS ? i0 + 68 : CVT_ITEMS;
            LAS float* scr = (LAS float*)(ldsl + wid * 16384);
            convert_layer(a, l + 1, (bf16*)(ws + (((l + 1) & 1) ? WS_W1 : WS_W0)), scr, i0 + wid, 8, lane, i1);
            __syncthreads();
        }
    } }
DI void phase_merge(const Args& a, LAS unsigned char* ldsl, int l) { PHASE_HEAD
    bf16* Y = (bf16*)(ws + WS_Y); bf16* Ta = (bf16*)(ws + WS_TA); bf16* Tb = (bf16*)(ws + WS_TB); bf16* MG = (bf16*)(ws + WS_MG);
    { Gemm g{Y, wset + W_UA, NTOK, 1024, 512, 768, 512}; PanelOrder S{2, G, c}; EpiBf<0> E{Ta, DM, nullptr}; GEMM_PHASE(EpiBf<0>, PanelOrder, g, S, E); }
    { Gemm g{Y + 512, wset + W_UB, NTOK, 1024, 256, 768, 256}; PanelOrder S{2, G, c}; EpiBf<0> E{Tb, DM, nullptr}; GEMM_PHASE(EpiBf<0>, PanelOrder, g, S, E); }
    { Gemm g{xb, wset + W_G, NTOK, 2048, 1024, 1024, 1024}; PanelOrder S{4, G, c}; EpiGate E{Ta, Tb, MG, rsum, (LAS float*)(ldsl + 131072)}; GEMM_PHASE(EpiGate, PanelOrder, g, S, E); } }
DI void phase_wout(const Args& a, LAS unsigned char* ldsl, int l) { PHASE_HEAD
    bf16* MG = (bf16*)(ws + WS_MG);
    Gemm g{MG, wset + W_O, NTOK, 1024, 1024, 1024, 1024}; pg8::StaticOrder S; S.init(NTOK, 1024, G, c);
    EpiResid E{xb, rsum}; GEMM_PHASE(EpiResid, pg8::StaticOrder, g, S, E); }
DI void phase_ffn_in(const Args& a, LAS unsigned char* ldsl, int l) { PHASE_HEAD
    bf16* ACT = (bf16*)(ws + WS_ACT);
    Gemm g{xb, wset + W_FF, NTOK, 2 * DFF, 1024, 1024, 1024}; pg8::StaticOrder S; S.init(NTOK, 2 * DFF, G, c); EpiSwiglu E{ACT, rsum, (LAS float*)(ldsl + 131072)}; GEMM_PHASE(EpiSwiglu, pg8::StaticOrder, g, S, E); }
DI void phase_ffn_out(const Args& a, LAS unsigned char* ldsl, int l) { PHASE_HEAD
    bf16* ACT = (bf16*)(ws + WS_ACT);
    Gemm g{ACT, wset + W_FO, NTOK, 1024, DFF, DFF, DFF}; pg8::StaticOrder S; S.init(NTOK, 1024, G, c);
    EpiResid E{xb, rsum}; GEMM_PHASE(EpiResid, pg8::StaticOrder, g, S, E); }
DI void phase_final(const Args& a) { const int l = 0; PHASE_HEAD
    const int gw = c * 8 + wid, NGW = G * 8; float* out = (float*)a.p[launder_i(16)];
    const GAS f32x4* gn = (const GAS f32x4*)a.p[launder_i(15)] + lane;
    for (int row = 4 * gw; row < NTOK; row += 4 * NGW) {
        const GAS u32x2* xr = (const GAS u32x2*)(xb + (size_t)row * DM) + lane;
        u32x2 w[16];
#pragma unroll
        for (int j = 0; j < 16; ++j) w[j] = xr[64 * j];
        float s[4] = {0.f, 0.f, 0.f, 0.f};
#pragma unroll
        for (int j = 0; j < 16; ++j) { const float e0 = __uint_as_float(w[j].x << 16), e1 = __uint_as_float(w[j].x & 0xffff0000u), e2 = __uint_as_float(w[j].y << 16), e3 = __uint_as_float(w[j].y & 0xffff0000u);
            s[j >> 2] += (e0 * e0 + e1 * e1) + (e2 * e2 + e3 * e3); }
        float r[4];
#pragma unroll
        for (int k = 0; k < 4; ++k) r[k] = rsqrtf(wave_sum(s[k]) * (1.f / 1024.f) + EPS);
        GAS f32x4* o = (GAS f32x4*)(out + (size_t)row * DM) + lane;
#pragma unroll
        for (int j = 0; j < 16; ++j) { f32x4 v; v.x = __uint_as_float(w[j].x << 16); v.y = __uint_as_float(w[j].x & 0xffff0000u); v.z = __uint_as_float(w[j].y << 16); v.w = __uint_as_float(w[j].y & 0xffff0000u);
            o[64 * j] = v * r[j >> 2] * gn[64 * (j & 3)]; }
    } }

__global__ void __launch_bounds__(512, 2) fwd_megakernel(Args a) {
    extern __shared__ __attribute__((aligned(16))) unsigned char lds[];
    cg::grid_group grid = cg::this_grid();
    LAS unsigned char* ldsl = (LAS unsigned char*)lds;
    volatile LAS unsigned* xst = (volatile LAS unsigned*)(ldsl + LDS_BYTES - 64);
    if (threadIdx.x < 2) xst[threadIdx.x] = 0u;
    if (blockIdx.x == 0) { unsigned* bz = (unsigned*)a.p[launder_i(17)]; for (int i = threadIdx.x; i < XCD_BAR_WORDS + 64 * 40; i += 512) bz[i] = 0u; }
    __syncthreads();
    for (int rep = 0; rep < REP_PRO; ++rep) phase_prologue(a, ldsl);
    grid.sync();
    { XcdBarrier xb0 = xcd_barrier_post((unsigned*)a.p[launder_i(17)], xst); (void)xb0; }
#define GSYNC() do { XcdBarrier xb_; xb_.bar = (unsigned*)a.p[launder_i(17)]; xb_.x = xb_xcc_id(); xb_.st = xst; xcd_barrier(xb_); } while (0)
    for (int l = 0; l < DEPTH; ++l) {
        for (int rep = 0; rep < REP_P1; ++rep) { phase_inproj(a, ldsl, l); GSYNC(); }
        for (int rep = 0; rep < REP_P2; ++rep) { phase_compress_a(a, ldsl, l); GSYNC(); }
        for (int rep = 0; rep < REP_P3; ++rep) { phase_attn(a, ldsl, l); GSYNC(); }
        for (int rep = 0; rep < REP_P4; ++rep) { phase_merge(a, ldsl, l); GSYNC(); }
        phase_wout(a, ldsl, l); GSYNC();
        for (int rep = 0; rep < REP_SYNC; ++rep) GSYNC();
        for (int rep = 0; rep < REP_P6; ++rep) { phase_ffn_in(a, ldsl, l); GSYNC(); }
        phase_ffn_out(a, ldsl, l); GSYNC();
    }
    phase_final(a);
}

extern "C" void kernel_launch(void* const* d_in, const int* in_sizes, int n_in, void* d_out, int out_size, void* d_ws, size_t ws_size, hipStream_t stream) {
    static int grid = 0;
    if (grid == 0) {
        if (n_in != 16 || out_size != NTOK * DM || ws_size < WS_END) { fprintf(stderr, "kernel_launch: unexpected problem shape (n_in %d, out %d, ws %zu)\n", n_in, out_size, ws_size); grid = -1; return; }
        int dev = 0, cus = 0, per_cu = 0;
        if (hipGetDevice(&dev) != hipSuccess || hipDeviceGetAttribute(&cus, hipDeviceAttributeMultiprocessorCount, dev) != hipSuccess) { grid = -1; return; }
        if (hipFuncSetAttribute((const void*)fwd_megakernel, hipFuncAttributeMaxDynamicSharedMemorySize, LDS_BYTES) != hipSuccess) { fprintf(stderr, "hipFuncSetAttribute failed\n"); grid = -1; return; }
        if (hipOccupancyMaxActiveBlocksPerMultiprocessor(&per_cu, (const void*)fwd_megakernel, 512, LDS_BYTES) != hipSuccess || per_cu < 1) { fprintf(stderr, "occupancy query: %d\n", per_cu); (void)hipGetLastError(); }
        grid = cus;
        if (grid < 64) { fprintf(stderr, "kernel_launch: too few CUs\n"); grid = -1; return; }
    }
    if (grid < 0) return;
    Args a{};
    for (int i = 0; i < 16; ++i) a.p[i] = (const float*)d_in[i];
    a.p[16] = (const float*)d_out; a.p[17] = (const float*)d_ws;
    void* args[] = {&a};
    hipError_t e = hipLaunchCooperativeKernel((const void*)fwd_megakernel, dim3(grid), dim3(512), args, LDS_BYTES, stream);
    if (e != hipSuccess) fprintf(stderr, "cooperative launch failed: %s (grid %d)\n", hipGetErrorString(e), grid);
}
```

```cpp
#include <hip/hip_runtime.h>
#include <hip/hip_cooperative_groups.h>
#include <cstdio>
#include <cstdint>
namespace cg = cooperative_groups;
namespace pg8 {
#define PG8_LAS __attribute__((address_space(3)))
typedef unsigned short bf16_t;
typedef short bf16x8 __attribute__((ext_vector_type(8)));
typedef float f32x4 __attribute__((ext_vector_type(4)));
typedef unsigned u32x4 __attribute__((ext_vector_type(4)));
constexpr int BM = 256, BK = 64, HALF = 128, HTB = HALF * BK * 2  , STAGE_BYTES = 8 * HTB, NXCD = 8, WGM = 8;

__host__ __device__ __forceinline__ int lds_byte(int r, int c) { const int st = (r >> 4) * 2 + (c >> 5), rr = r & 15, cc = c & 31, ob = rr * 64 + cc * 2; return st * 1024 + (ob ^ (((ob >> 9) & 1) << 5)); }
__host__ __device__ __forceinline__ void stage_rc(int b, int& R, int& C) { const int st = b / 1024, sb = b % 1024, swz = sb ^ (((sb >> 9) & 1) << 5); R = (st >> 1) * 16 + swz / 64; C = (st & 1) * 32 + (swz % 64) / 2; }
__host__ __device__ __forceinline__ int perm32(int rho) { const int n = rho >> 4, i = rho & 15; return 8 * (i >> 2) + 4 * n + (i & 3); }

__device__ __forceinline__ int pg8_tid() { int t = threadIdx.x; asm volatile("" : "+v"(t)); return t; }
struct Unit { int pm, pn; };
struct Gemm { const bf16_t* A; const bf16_t* Bt; int M, N, K, lda, ldb; };

struct StaticOrder {
    int nM, nN, nwg, G, c;
    __host__ __device__ void init(int M, int N, int G_, int c_) { nM = M / BM; nN = N / BM; nwg = nM * nN; G = G_; c = c_; }
    __host__ __device__ bool next(int i, Unit& u) const {
        const long L = (long)i * G + c; if (L >= nwg) return false;
        int wgid = (int)L; { const int q = nwg / NXCD, r = nwg % NXCD, xcd = wgid % NXCD, off = wgid / NXCD; wgid = (xcd < r ? xcd * (q + 1) : r * (q + 1) + (xcd - r) * q) + off; }
        const int nig = WGM * nN, gid = wgid / nig, fm = gid * WGM, gsz = (nM - fm) < WGM ? (nM - fm) : WGM;
        u.pm = fm + ((wgid % nig) % gsz); u.pn = (wgid % nig) / gsz; return true;
    }
    __device__ __forceinline__ void a_ready(const Unit&) const {}
    __device__ __forceinline__ void done(const Unit&) const {}
};
template <class Epi, class Sched, bool ALIGN_EPI = false, bool SP2 = false>
__device__ __forceinline__ void gemm_phase(PG8_LAS unsigned char* lds, const Gemm g, const Sched& S, const Epi& E) {
    const int tid = pg8_tid(), wid = __builtin_amdgcn_readfirstlane(tid >> 6), lane = tid & 63, wr = wid >> 2, wc = wid & 3, fr = lane & 15, fq = lane >> 4;
    const int K = g.K, nt = K / BK;
    unsigned voffA[2], voffB[2];
#pragma unroll
    for (int i = 0; i < 2; ++i) { int R, C; stage_rc(tid * 16 + i * 8192, R, C); const int Rb = Epi::PERM ? ((R & ~31) + perm32(R & 31)) : R;
        voffA[i] = (unsigned)(R * g.lda + C) * 2u; voffB[i] = (unsigned)(Rb * g.ldb + C) * 2u; }
    const size_t kstep = (size_t)(BK * 2);
    const size_t hstepB = (size_t)HALF * g.ldb * 2, hstepA = (size_t)HALF * g.lda * 2;
    const size_t tstepB = 2 * hstepB, tstepA = 2 * hstepA;
    const unsigned ldsw = (unsigned)wid * 1024u;
    const int aoff = lds_byte(wr * 64 + fr, fq * 8), boff = lds_byte(wc * 32 + fr, fq * 8);
#define PG8_SA(b, h) (((b) * 2 + (h)) * HTB)
#define PG8_SB(b, h) ((4 + (b) * 2 + (h)) * HTB)
#define PG8_STAGE(bufoff, gbase, voff) do { _Pragma("unroll") for (int _i = 0; _i < 2; ++_i) \
        __builtin_amdgcn_global_load_lds((const unsigned*)((const char*)(gbase) + (voff)[_i]), (PG8_LAS unsigned*)(lds + (bufoff) + ldsw + _i * 8192), 16, 0, 0); } while (0)
#define PG8_LDA(dst, b, h) do { _Pragma("unroll") for (int m = 0; m < 4; ++m) _Pragma("unroll") for (int k = 0; k < 2; ++k) dst[m][k] = *(const PG8_LAS bf16x8*)(lds + PG8_SA(b, h) + aoff + m * 2048 + k * 1024); } while (0)
#define PG8_LDB(dst, b, h) do { _Pragma("unroll") for (int n = 0; n < 2; ++n) _Pragma("unroll") for (int k = 0; k < 2; ++k) dst[n][k] = *(const PG8_LAS bf16x8*)(lds + PG8_SB(b, h) + boff + n * 2048 + k * 1024); } while (0)
#define PG8_MMA(ai, bj, At, Bt) do { __builtin_amdgcn_s_setprio(1); _Pragma("unroll") for (int m = 0; m < 4; ++m) _Pragma("unroll") for (int n = 0; n < 2; ++n) _Pragma("unroll") for (int k = 0; k < 2; ++k) \
        acc[ai][bj][m][n] = __builtin_amdgcn_mfma_f32_16x16x32_bf16(Bt[n][k], At[m][k], acc[ai][bj][m][n], 0, 0, 0); __builtin_amdgcn_s_setprio(0); } while (0)
#define PG8_WAIT_V(n) asm volatile("s_waitcnt vmcnt(" #n ")" ::: "memory")
#define PG8_WAIT_L(n) asm volatile("s_waitcnt lgkmcnt(" #n ")" ::: "memory")
#define PG8_BAR __builtin_amdgcn_s_barrier()
#define PG8_SCHED __builtin_amdgcn_sched_barrier(0)
    Unit cur, nxt; int ui = 0;
    if (!S.next(0, cur)) return;
    f32x4 acc[2][2][4][2];
#pragma unroll
    for (int a = 0; a < 2; ++a)
#pragma unroll
        for (int b = 0; b < 2; ++b)
#pragma unroll
            for (int m = 0; m < 4; ++m)
#pragma unroll
                for (int n = 0; n < 2; ++n) acc[a][b][m][n] = (f32x4){0.f, 0.f, 0.f, 0.f};
    bf16x8 At[4][2], B0[2][2], B1[2][2];
    const char* cA = (const char*)g.A + (size_t)cur.pm * tstepA; const char* cB = (const char*)g.Bt + (size_t)cur.pn * tstepB;
    S.a_ready(cur);
    if constexpr (SP2) {
        PG8_STAGE(PG8_SB(0, 0), cB, voffB); PG8_STAGE(PG8_SB(0, 1), cB + hstepB, voffB); PG8_STAGE(PG8_SA(0, 0), cA, voffA); PG8_STAGE(PG8_SA(0, 1), cA + hstepA, voffA);
        if (wr == 1) PG8_BAR;
        PG8_WAIT_V(2); PG8_BAR;
        PG8_STAGE(PG8_SB(1, 0), cB + kstep, voffB); PG8_STAGE(PG8_SA(1, 0), cA + kstep, voffA); PG8_STAGE(PG8_SB(1, 1), cB + hstepB + kstep, voffB);
        PG8_WAIT_V(6); PG8_BAR;
    } else {
        PG8_STAGE(PG8_SB(0, 0), cB, voffB); PG8_STAGE(PG8_SA(0, 0), cA, voffA); PG8_STAGE(PG8_SB(0, 1), cB + hstepB, voffB); PG8_STAGE(PG8_SA(0, 1), cA + hstepA, voffA);
        if (wr == 1) PG8_BAR;
        PG8_WAIT_V(4); PG8_BAR;
        PG8_STAGE(PG8_SB(1, 0), cB + kstep, voffB); PG8_STAGE(PG8_SA(1, 0), cA + kstep, voffA); PG8_STAGE(PG8_SB(1, 1), cB + hstepB + kstep, voffB);
        PG8_WAIT_V(6); PG8_BAR;
    }
    for (;;) {
        const bool has_next = S.next(ui + 1, nxt);
        const char* nA = has_next ? (const char*)g.A + (size_t)nxt.pm * tstepA : cA; const char* nB = has_next ? (const char*)g.Bt + (size_t)nxt.pn * tstepB : cB;
        for (int t = 0; t < nt; t += 2) {
            const bool last = (t == nt - 2);
            const char* a1 = cA + (size_t)(t + 1) * kstep;
            const char* a2 = last ? nA : cA + (size_t)(t + 2) * kstep; const char* b2 = last ? nB : cB + (size_t)(t + 2) * kstep;
            const char* a3 = a2 + kstep; const char* b3 = b2 + kstep;
            if (last && has_next) S.a_ready(nxt);
            if constexpr (SP2) {
            PG8_LDB(B0, 0, 0); PG8_LDB(B1, 0, 1); PG8_SCHED; PG8_LDA(At, 0, 0); PG8_STAGE(PG8_SA(1, 1), a1 + hstepA, voffA);
            PG8_WAIT_V(8); PG8_WAIT_L(0); PG8_BAR; PG8_MMA(0, 0, At, B0); PG8_MMA(0, 1, At, B1); PG8_BAR; PG8_SCHED;
            PG8_LDA(At, 0, 1); PG8_STAGE(PG8_SB(0, 0), b2, voffB); PG8_STAGE(PG8_SB(0, 1), b2 + hstepB, voffB); PG8_STAGE(PG8_SA(0, 0), a2, voffA);
            PG8_WAIT_V(8); PG8_WAIT_L(0); PG8_BAR; PG8_MMA(1, 0, At, B0); PG8_MMA(1, 1, At, B1); PG8_BAR; PG8_SCHED;
            PG8_LDB(B0, 1, 0); PG8_LDB(B1, 1, 1); PG8_SCHED; PG8_LDA(At, 1, 0); PG8_STAGE(PG8_SA(0, 1), a2 + hstepA, voffA);
            PG8_WAIT_V(8); PG8_WAIT_L(0); PG8_BAR; PG8_MMA(0, 0, At, B0); PG8_MMA(0, 1, At, B1); PG8_BAR; PG8_SCHED;
            PG8_LDA(At, 1, 1); PG8_STAGE(PG8_SB(1, 0), b3, voffB); PG8_STAGE(PG8_SB(1, 1), b3 + hstepB, voffB); PG8_STAGE(PG8_SA(1, 0), a3, voffA);
            PG8_WAIT_V(8); PG8_WAIT_L(0); PG8_BAR; PG8_MMA(1, 0, At, B0); PG8_MMA(1, 1, At, B1); PG8_BAR; PG8_SCHED;
            } else {
            PG8_LDB(B0, 0, 0); PG8_SCHED; PG8_LDA(At, 0, 0); PG8_STAGE(PG8_SA(1, 1), a1 + hstepA, voffA);
            PG8_WAIT_L(8); PG8_BAR; PG8_WAIT_L(0); PG8_MMA(0, 0, At, B0); PG8_BAR; PG8_SCHED;
            PG8_LDB(B1, 0, 1); PG8_STAGE(PG8_SB(0, 0), b2, voffB);
            PG8_BAR; PG8_WAIT_L(0); PG8_MMA(0, 1, At, B1); PG8_BAR;
            PG8_LDA(At, 0, 1); PG8_STAGE(PG8_SA(0, 0), a2, voffA);
            PG8_BAR; PG8_WAIT_L(0); PG8_MMA(1, 0, At, B0); PG8_BAR; PG8_SCHED;
            PG8_STAGE(PG8_SB(0, 1), b2 + hstepB, voffB);
            PG8_WAIT_V(6); PG8_BAR; PG8_MMA(1, 1, At, B1); PG8_BAR;
            PG8_LDB(B0, 1, 0); PG8_SCHED; PG8_LDA(At, 1, 0); PG8_STAGE(PG8_SA(0, 1), a2 + hstepA, voffA);
            PG8_WAIT_L(8); PG8_BAR; PG8_WAIT_L(0); PG8_MMA(0, 0, At, B0); PG8_BAR; PG8_SCHED;
            PG8_LDB(B1, 1, 1); PG8_STAGE(PG8_SB(1, 0), b3, voffB);
            PG8_BAR; PG8_WAIT_L(0); PG8_MMA(0, 1, At, B1); PG8_BAR;
            PG8_LDA(At, 1, 1); PG8_STAGE(PG8_SA(1, 0), a3, voffA);
            PG8_BAR; PG8_WAIT_L(0); PG8_MMA(1, 0, At, B0); PG8_BAR; PG8_SCHED;
            PG8_STAGE(PG8_SB(1, 1), b3 + hstepB, voffB);
            PG8_WAIT_V(6); PG8_BAR; PG8_MMA(1, 1, At, B1); PG8_BAR;
            }
        }
        if constexpr (ALIGN_EPI) { if (wr == 0) PG8_BAR; }
        if constexpr (!Epi::AFTER_DRAIN) { E(acc, cur, wr, wc, fr, fq); S.done(cur); }
        if (!has_next) break;
#pragma unroll
        for (int a = 0; a < 2; ++a)
#pragma unroll
            for (int b = 0; b < 2; ++b)
#pragma unroll
                for (int m = 0; m < 4; ++m)
#pragma unroll
                    for (int n = 0; n < 2; ++n) acc[a][b][m][n] = (f32x4){0.f, 0.f, 0.f, 0.f};
        cur = nxt; cA = nA; cB = nB; ++ui;
        if constexpr (ALIGN_EPI) { if (wr == 1) PG8_BAR; }
    }
    PG8_WAIT_V(0);
    if constexpr (!ALIGN_EPI) { if (wr == 0) PG8_BAR; }
    PG8_BAR;
    if constexpr (Epi::AFTER_DRAIN) { E.fused(acc, cur, wr, wc, fr, fq, lds, wid, lane); S.done(cur); }
#undef PG8_SA
#undef PG8_SB
#undef PG8_STAGE
#undef PG8_LDA
#undef PG8_LDB
#undef PG8_MMA
#undef PG8_WAIT_V
#undef PG8_WAIT_L
#undef PG8_BAR
#undef PG8_SCHED
}
}
#define DI __device__ __forceinline__
#define GAS __attribute__((address_space(1)))
#define LAS __attribute__((address_space(3)))
typedef unsigned short bf16;
typedef short bf16x8 __attribute__((ext_vector_type(8)));
typedef float f32x4 __attribute__((ext_vector_type(4)));
typedef float f32x16 __attribute__((ext_vector_type(16)));
typedef float f32x2 __attribute__((ext_vector_type(2)));
typedef unsigned u32x4 __attribute__((ext_vector_type(4)));
typedef unsigned u32x2 __attribute__((ext_vector_type(2)));
typedef __bf16 bf2_t __attribute__((ext_vector_type(2)));
using pg8::Unit; using pg8::Gemm;

constexpr int BATCH = 4, SEQ = 8192, DM = 1024, DEPTH = 4, NTOK = BATCH * SEQ, DFF = 2816;
constexpr int D_IN = 5656, N_IN_PAD = 3840, NPR = 57;
constexpr float LOG2E = 1.4426950408889634f, C2 = 0.125f * 1.4426950408889634f, EPS = 1e-6f;
constexpr size_t MiB = 1u << 20;
constexpr size_t WS_RSUM = 1 * MiB, WS_BIAS = 3 * MiB, WS_KC = 4 * MiB, WS_VCT = 4 * MiB + 512 * 1024, WS_H = 5 * MiB;
constexpr size_t WS_W0 = 10 * MiB, WS_W1 = 44 * MiB, WS_XB = 78 * MiB, WS_Y = 142 * MiB, WS_VT = 190 * MiB, WS_PR = 254 * MiB;
constexpr size_t WS_TA = WS_PR, WS_TB = WS_PR + 64 * MiB, WS_MG = WS_PR + 128 * MiB, WS_ACT = WS_PR, WS_PART = 482 * MiB, WS_END = 498 * MiB;
constexpr size_t W_IN = 0, W_G = W_IN + (size_t)3840 * 1024, W_FF = W_G + (size_t)2048 * 1024, W_FO = W_FF + (size_t)5632 * 1024, W_O = W_FO + (size_t)1024 * 2816,
                 W_UA = W_O + (size_t)1024 * 1024, W_UB = W_UA + (size_t)1024 * 512, W_CK1 = W_UB + (size_t)1024 * 256, W_CV1 = W_CK1 + (size_t)256 * 2048,
                 W_CK2 = W_CV1 + (size_t)256 * 2048, W_CV2 = W_CK2 + (size_t)256 * 256, W_TOTAL = W_CV2 + (size_t)256 * 256;
static_assert(W_TOTAL * 2 <= 34 * MiB, "weight set");
constexpr int LDS_BYTES = 163840;

struct Args { const float* p[18]; };

DI unsigned pk2(float lo, float hi) { f32x2 v = {lo, hi}; return __builtin_bit_cast(unsigned, __builtin_convertvector(v, bf2_t)); }
DI float bf2f(unsigned short b) { return __uint_as_float((unsigned)b << 16); }
DI float fast_exp2(float x) { return __builtin_amdgcn_exp2f(x); }
DI float sigmoidf_(float x) { return __builtin_amdgcn_rcpf(1.f + fast_exp2(-x * LOG2E)); }
DI float siluf_(float x) { return x * sigmoidf_(x); }
DI int launder_i(int v) { asm volatile("" : "+s"(v)); return v; }
DI float wave_sum(float v) {
#pragma unroll
    for (int o = 1; o < 64; o <<= 1) v += __shfl_xor(v, o);
    return v;
}
#define LDS_WAIT() asm volatile("s_waitcnt lgkmcnt(0)" ::: "memory")

typedef const f32x4 (&AccRef)[2][2][4][2];
DI float load_rs1(const float* rsum, int row) {
    const GAS f32x4* p = (const GAS f32x4*)(rsum + (size_t)row * 16);
    const f32x4 a = p[0], b = p[1], c = p[2], d = p[3];
    const float s = (((a.x + a.y) + (a.z + a.w)) + ((b.x + b.y) + (b.z + b.w))) + (((c.x + c.y) + (c.z + c.w)) + ((d.x + d.y) + (d.z + d.w)));
    return rsqrtf(s * (1.f / 1024.f) + EPS);
}
DI void unit_rs_table(const float* rsum, int pm, LAS float* rsl) {
    const int tid = pg8::pg8_tid();
    if (tid < 256) rsl[tid] = load_rs1(rsum, pm * 256 + tid);
    asm volatile("s_waitcnt lgkmcnt(0)\n\ts_barrier" ::: "memory");
}
DI void load_rs(const float* rsum, int row0, float (&rs)[2][4]) {
#pragma unroll
    for (int ai = 0; ai < 2; ++ai)
#pragma unroll
        for (int m = 0; m < 4; ++m) {
            const GAS f32x4* p = (const GAS f32x4*)(rsum + (size_t)(row0 + ai * 128 + m * 16) * 16);
            const f32x4 a = p[0], b = p[1], c = p[2], d = p[3];
            const float s = (((a.x + a.y) + (a.z + a.w)) + ((b.x + b.y) + (b.z + b.w))) + (((c.x + c.y) + (c.z + c.w)) + ((d.x + d.y) + (d.z + d.w)));
            rs[ai][m] = rsqrtf(s * (1.f / 1024.f) + EPS);
        }
}
struct EpiProj {
    static constexpr bool PERM = true, AFTER_DRAIN = false;
    bf16* PR; const float* rsum; LAS float* rsl;
    DI void operator()(AccRef acc, const Unit& u, int wr, int wc, int fr, int fq) const {
        const int row0 = u.pm * 256 + wr * 64 + fr;
        unit_rs_table(rsum, u.pm, rsl);
#pragma unroll
        for (int ai = 0; ai < 2; ++ai)
#pragma unroll
            for (int m = 0; m < 4; ++m) {
                const int row = row0 + ai * 128 + m * 16; const float rs = rsl[row - u.pm * 256];
#pragma unroll
                for (int bj = 0; bj < 2; ++bj) {
                    const int c0 = u.pn * 256 + bj * 128 + wc * 32 + 8 * fq, cb = c0 >> 6;
                    if (cb >= NPR) continue;
                    const float sc = (cb < 8 || (cb >= 20 && cb < 32)) ? C2 : 1.f; const bool sig = (cb == 56);
                    const float f = rs * sc;
                    f32x4 v0 = acc[ai][bj][m][0] * f, v1 = acc[ai][bj][m][1] * f;
                    if (sig) { for (int i = 0; i < 4; ++i) { v0[i] = sigmoidf_(v0[i]); v1[i] = sigmoidf_(v1[i]); } }
                    u32x4 w; w.x = pk2(v0[0], v0[1]); w.y = pk2(v0[2], v0[3]); w.z = pk2(v1[0], v1[1]); w.w = pk2(v1[2], v1[3]);
                    if (cb >= 32 && cb < 44) {
                        const int dsh = ((cb - 32) >> 2) * 2, t = row & (SEQ - 1), p = ((t & ((1 << dsh) - 1)) << (13 - dsh)) + (t >> dsh), ch = (c0 & 63) >> 3;
                        *(GAS u32x4*)(PR + ((size_t)cb * NTOK + (size_t)(row - t)) * 64 + (size_t)(p >> 5) * 2048 + ((((ch >> 1) * 32 + (p & 31)) * 2 + (ch & 1)) * 8)) = w;
                    } else
                    *(GAS u32x4*)(PR + ((size_t)cb * NTOK + row) * 64 + (c0 & 63)) = w;
                }
            }
    }
};
template <int ACT> struct EpiBf {
    static constexpr bool PERM = true, AFTER_DRAIN = false;
    bf16* O; int ldc; const float* bias;
    DI void operator()(AccRef acc, const Unit& u, int wr, int wc, int fr, int fq) const {
        const int row0 = u.pm * 256 + wr * 64 + fr;
#pragma unroll
        for (int bj = 0; bj < 2; ++bj) {
            const int c0 = u.pn * 256 + bj * 128 + wc * 32 + 8 * fq;
            f32x4 b0 = {0.f, 0.f, 0.f, 0.f}, b1 = b0;
            if (ACT) { b0 = *(const GAS f32x4*)(bias + c0); b1 = *(const GAS f32x4*)(bias + c0 + 4); }
#pragma unroll
            for (int ai = 0; ai < 2; ++ai)
#pragma unroll
                for (int m = 0; m < 4; ++m) {
                    const int row = row0 + ai * 128 + m * 16;
                    f32x4 v0 = acc[ai][bj][m][0] + b0, v1 = acc[ai][bj][m][1] + b1;
                    if (ACT) { for (int i = 0; i < 4; ++i) { v0[i] = siluf_(v0[i]); v1[i] = siluf_(v1[i]); } }
                    u32x4 w; w.x = pk2(v0[0], v0[1]); w.y = pk2(v0[2], v0[3]); w.z = pk2(v1[0], v1[1]); w.w = pk2(v1[2], v1[3]);
                    *(GAS u32x4*)(O + (size_t)row * ldc + c0) = w;
                }
        }
    }
};
struct EpiCmp {
    static constexpr bool PERM = true, AFTER_DRAIN = false;
    bf16* O; int mode;
    DI void operator()(AccRef acc, const Unit& u, int wr, int wc, int fr, int fq) const {
        if (u.pn != 0 || wc >= 2) return;
        const int row0 = u.pm * 256 + wr * 64 + fr; const int c0 = wc * 32 + 8 * fq;
#pragma unroll
        for (int ai = 0; ai < 2; ++ai)
#pragma unroll
            for (int m = 0; m < 4; ++m) {
                const int row = row0 + ai * 128 + m * 16;
                const f32x4 v0 = acc[ai][0][m][0], v1 = acc[ai][0][m][1];
                if (mode == 0) {
                    u32x4 w; w.x = pk2(v0[0], v0[1]); w.y = pk2(v0[2], v0[3]); w.z = pk2(v1[0], v1[1]); w.w = pk2(v1[2], v1[3]);
                    *(GAS u32x4*)(O + (size_t)row * 64 + c0) = w;
                } else {
                    GAS bf16* p = (GAS bf16*)O + ((size_t)(row >> 9) * 64 + c0) * 512 + (row & 511);
#pragma unroll
                    for (int i = 0; i < 4; ++i) { p[(size_t)i * 512] = (bf16)(pk2(v0[i], 0.f) & 0xffffu); p[(size_t)(4 + i) * 512] = (bf16)(pk2(v1[i], 0.f) & 0xffffu); }
                }
            }
    }
};
struct EpiGate {
    static constexpr bool PERM = true, AFTER_DRAIN = false;
    const bf16* Ta; const bf16* Tb; bf16* MG; const float* rsum; LAS float* rsl;
    DI void operator()(AccRef acc, const Unit& u, int wr, int wc, int fr, int fq) const {
        const int row0 = u.pm * 256 + wr * 64 + fr; const int c0 = u.pn * 128 + wc * 32 + 8 * fq;
        unit_rs_table(rsum, u.pm, rsl);
#pragma unroll
        for (int ai = 0; ai < 2; ++ai) {
            u32x4 ta[4], tb[4];
#pragma unroll
            for (int m = 0; m < 4; ++m) { const size_t off = (size_t)(row0 + ai * 128 + m * 16) * DM + c0; ta[m] = *(const GAS u32x4*)(Ta + off); tb[m] = *(const GAS u32x4*)(Tb + off); }
#pragma unroll
            for (int m = 0; m < 4; ++m) {
                const int row = row0 + ai * 128 + m * 16; const float f = rsl[row - u.pm * 256];
                float o[8];
#pragma unroll
                for (int i = 0; i < 8; ++i) {
                    const float ga = acc[ai][0][m][i >> 2][i & 3] * f, gb = acc[ai][1][m][i >> 2][i & 3] * f;
                    const unsigned wa = ta[m][i >> 1], wb = tb[m][i >> 1];
                    const float a = (i & 1) ? __uint_as_float(wa & 0xffff0000u) : __uint_as_float(wa << 16);
                    const float b = (i & 1) ? __uint_as_float(wb & 0xffff0000u) : __uint_as_float(wb << 16);
                    o[i] = sigmoidf_(ga) * a + sigmoidf_(gb) * b;
                }
                u32x4 w; w.x = pk2(o[0], o[1]); w.y = pk2(o[2], o[3]); w.z = pk2(o[4], o[5]); w.w = pk2(o[6], o[7]);
                *(GAS u32x4*)(MG + (size_t)row * DM + c0) = w;
            }
        }
    }
};
struct EpiSwiglu {
    static constexpr bool PERM = true, AFTER_DRAIN = false;
    bf16* ACT; const float* rsum; LAS float* rsl;
    DI void operator()(AccRef acc, const Unit& u, int wr, int wc, int fr, int fq) const {
        const int row0 = u.pm * 256 + wr * 64 + fr; const int c0 = u.pn * 128 + wc * 32 + 8 * fq;
        unit_rs_table(rsum, u.pm, rsl);
#pragma unroll
        for (int ai = 0; ai < 2; ++ai)
#pragma unroll
            for (int m = 0; m < 4; ++m) {
                const int row = row0 + ai * 128 + m * 16; const float f = rsl[row - u.pm * 256];
                float o[8];
#pragma unroll
                for (int i = 0; i < 8; ++i) { const float gt = acc[ai][0][m][i >> 2][i & 3] * f, up = acc[ai][1][m][i >> 2][i & 3] * f; o[i] = siluf_(gt) * up; }
                u32x4 w; w.x = pk2(o[0], o[1]); w.y = pk2(o[2], o[3]); w.z = pk2(o[4], o[5]); w.w = pk2(o[6], o[7]);
                *(GAS u32x4*)(ACT + (size_t)row * DFF + c0) = w;
            }
    }
};
struct EpiResid {
    static constexpr bool PERM = true, AFTER_DRAIN = false;
    bf16* xb; float* rsum;
    DI void operator()(AccRef acc, const Unit& u, int wr, int wc, int fr, int fq) const {
        const int row0 = u.pm * 256 + wr * 64 + fr;
#pragma unroll
        for (int ai = 0; ai < 2; ++ai) {
            u32x4 xr[4][2];
#pragma unroll
            for (int m = 0; m < 4; ++m)
#pragma unroll
                for (int bj = 0; bj < 2; ++bj) xr[m][bj] = *(const GAS u32x4*)(xb + (size_t)(row0 + ai * 128 + m * 16) * DM + u.pn * 256 + bj * 128 + wc * 32 + 8 * fq);
#pragma unroll
            for (int m = 0; m < 4; ++m) {
                const int row = row0 + ai * 128 + m * 16; float ss = 0.f;
#pragma unroll
                for (int bj = 0; bj < 2; ++bj) {
                    const int c0 = u.pn * 256 + bj * 128 + wc * 32 + 8 * fq; const size_t off = (size_t)row * DM + c0;
                    float v[8];
#pragma unroll
                    for (int i = 0; i < 4; ++i) { v[2 * i] = __uint_as_float(xr[m][bj][i] << 16) + acc[ai][bj][m][(2 * i) >> 2][(2 * i) & 3]; v[2 * i + 1] = __uint_as_float(xr[m][bj][i] & 0xffff0000u) + acc[ai][bj][m][(2 * i + 1) >> 2][(2 * i + 1) & 3]; }
                    u32x4 w; w.x = pk2(v[0], v[1]); w.y = pk2(v[2], v[3]); w.z = pk2(v[4], v[5]); w.w = pk2(v[6], v[7]);
                    *(GAS u32x4*)(xb + off) = w;
#pragma unroll
                    for (int i = 0; i < 4; ++i) { const float lo = __uint_as_float(w[i] << 16), hi_ = __uint_as_float(w[i] & 0xffff0000u); ss += lo * lo + hi_ * hi_; }
                }
                ss += __shfl_xor(ss, 16); ss += __shfl_xor(ss, 32);
                if (fq == 0) rsum[(size_t)row * 16 + u.pn * 4 + wc] = ss;
            }
        }
    }
};
struct EpiF32 {
    static constexpr bool PERM = true, AFTER_DRAIN = false;
    float* O; int ldc;
    DI void operator()(AccRef acc, const Unit& u, int wr, int wc, int fr, int fq) const {
        const int row0 = u.pm * 256 + wr * 64 + fr;
#pragma unroll
        for (int bj = 0; bj < 2; ++bj) {
            const int c0 = u.pn * 256 + bj * 128 + wc * 32 + 8 * fq;
#pragma unroll
            for (int ai = 0; ai < 2; ++ai)
#pragma unroll
                for (int m = 0; m < 4; ++m) { GAS f32x4* p = (GAS f32x4*)(O + (size_t)(row0 + ai * 128 + m * 16) * ldc + c0); p[0] = acc[ai][bj][m][0]; p[1] = acc[ai][bj][m][1]; }
        }
    }
};
struct EpiGa {
    static constexpr bool PERM = true, AFTER_DRAIN = false;
    bf16* PR; const float* rsum;
    DI void operator()(AccRef acc, const Unit& u, int wr, int wc, int fr, int fq) const {
        if (wc != 0 || fq >= 3) return;
        const int row0 = u.pm * 256 + wr * 64 + fr;
#pragma unroll
        for (int ai = 0; ai < 2; ++ai)
#pragma unroll
            for (int m = 0; m < 4; ++m) {
                const int row = row0 + ai * 128 + m * 16; const float f = load_rs1(rsum, row);
                f32x4 v0 = acc[ai][0][m][0] * f, v1 = acc[ai][0][m][1] * f;
#pragma unroll
                for (int i = 0; i < 4; ++i) { v0[i] = sigmoidf_(v0[i]); v1[i] = sigmoidf_(v1[i]); }
                u32x4 w; w.x = pk2(v0[0], v0[1]); w.y = pk2(v0[2], v0[3]); w.z = pk2(v1[0], v1[1]); w.w = pk2(v1[2], v1[3]);
                *(GAS u32x4*)(PR + ((size_t)56 * NTOK + row) * 64 + 8 * fq) = w;
            }
    }
};
struct OneUnit { int pm, pn, has;
    DI bool next(int i, Unit& u) const { if (i > 0 || !has) return false; u.pm = pm; u.pn = pn; return true; }
    DI void a_ready(const Unit&) const {} DI void done(const Unit&) const {} };
struct PanelOrder { int per, G, c;
    DI bool next(int i, Unit& u) const { const int hp = c + (i / per) * G; if (hp >= 2 * (NTOK / 256)) return false; u.pm = hp >> 1; u.pn = (hp & 1) * per + (i % per); return true; }
    DI void a_ready(const Unit&) const {} DI void done(const Unit&) const {} };
#define XB_TMO      128
#define XB_XCNT(j)  (256  + 64 * (j))
#define XB_XSUB(j)  (1280 + 64 * (j))
#define XB_XGEN(j)  (2304 + 64 * (j))
#define XB_TOP      3328
#define XB_TOPGEN   3392
#define XCD_BAR_WORDS 3456
#define XB_SPIN_CAP (1u << 23)

__device__ __forceinline__ unsigned xb_ld(unsigned* p)              { return __hip_atomic_load(p, __ATOMIC_RELAXED, __HIP_MEMORY_SCOPE_AGENT); }
__device__ __forceinline__ unsigned xb_add(unsigned* p, unsigned v) { return __hip_atomic_fetch_add(p, v, __ATOMIC_RELAXED, __HIP_MEMORY_SCOPE_AGENT); }
__device__ __forceinline__ unsigned xb_xcc_id() { return (unsigned)__builtin_amdgcn_s_getreg((3 << 11) | 20) & 0xFu; }
#define XB_SPIN(cond, bar) do { unsigned _sp = 0; while (cond) { __builtin_amdgcn_s_sleep(1); \
    if ((++_sp & 255u) == 0u) { if (xb_ld(&(bar)[XB_TMO])) break; if (_sp > XB_SPIN_CAP) { atomicAdd(&(bar)[XB_TMO], 1u); break; } } } } while (0)

struct XcdBarrier {
    unsigned* bar; unsigned x;
    volatile LAS unsigned* st;
};

__device__ __forceinline__ XcdBarrier xcd_barrier_post(unsigned* bar, volatile LAS unsigned* st) {
    XcdBarrier b; b.bar = bar; b.x = xb_xcc_id(); b.st = st;
    if (threadIdx.x == 0) (void)xb_add(&bar[XB_XCNT(b.x)], 1u);
    return b;
}
__device__ __forceinline__ void xcd_barrier_complete(unsigned* bar, unsigned x, unsigned& nloc, unsigned& nx) {
    const unsigned G = gridDim.x * gridDim.y * gridDim.z;
    unsigned sum, cnt, mine, sp = 0u;
    for (;;) {
        sum = 0u; cnt = 0u; mine = 0u;
#pragma unroll
        for (unsigned j = 0; j < 16; ++j) { const unsigned c = xb_ld(&bar[XB_XCNT(j)]); sum += c; cnt += (c > 0u) ? 1u : 0u; mine = (j == x) ? c : mine; }
        if (sum == G) break;
        __builtin_amdgcn_s_sleep(1);
        if ((++sp & 255u) == 0u) { if (xb_ld(&bar[XB_TMO])) break; if (sp > XB_SPIN_CAP) { atomicAdd(&bar[XB_TMO], 1u); break; } }
    }
    nloc = mine > 0u ? mine : 1u; nx = cnt > 0u ? cnt : 1u;
}

__device__ __forceinline__ void xcd_barrier(const XcdBarrier& b) {
    asm volatile("s_waitcnt vmcnt(0)" ::: "memory");
    __syncthreads();
    if (threadIdx.x == 0) {
        unsigned* bar = b.bar;
        __builtin_amdgcn_s_waitcnt(0);
        unsigned nloc = b.st[0], nx = b.st[1];
        if (nloc == 0u) { xcd_barrier_complete(bar, b.x, nloc, nx); b.st[0] = nloc; b.st[1] = nx; }
        const unsigned old = xb_add(&bar[XB_XSUB(b.x)], 1u);
        const unsigned gen = old / nloc;
        if (old + 1u == (gen + 1u) * nloc) {
            __builtin_amdgcn_fence(__ATOMIC_RELEASE, "agent");
            asm volatile("s_waitcnt vmcnt(0)" ::: "memory");
            const unsigned og = xb_add(&bar[XB_TOP], 1u);
            const unsigned tg = og / nx;
            if (og + 1u == (tg + 1u) * nx) xb_add(&bar[XB_TOPGEN], 1u);
            else XB_SPIN(xb_ld(&bar[XB_TOPGEN]) == tg, bar);
            __builtin_amdgcn_fence(__ATOMIC_ACQUIRE, "agent");
            xb_add(&bar[XB_XGEN(b.x)], 1u);
            asm volatile("s_waitcnt vmcnt(0)" ::: "memory");
        } else {
            XB_SPIN(xb_ld(&bar[XB_XGEN(b.x)]) == gen, bar);
            __builtin_amdgcn_fence(__ATOMIC_ACQUIRE, "agent");
            asm volatile("s_waitcnt vmcnt(0)" ::: "memory");
        }
    }
    __syncthreads();
}
DI int srcmap(int mt, int n) {
    switch (mt) {
        case 0: return n < 1280 ? n : (n < 3584 ? n + 24 : (n < 3608 ? n - 3584 + 1280 : -1));
        case 1: { const int tile = n >> 8, w = n & 255, c = tile * 128 + (w & 127); return 3608 + (w < 128 ? c : 1024 + c); }
        case 2: { const int tile = n >> 8, w = n & 255, c = tile * 128 + (w & 127); return (w < 128) ? c : DFF + c; }
        case 9: case 10: return n < 64 ? n : -1;
        default: return n;
    }
}
DI void cvt_item(const float* W, int Nsrc, int K, const float* gain, int mt, bf16* WT, LAS float* scr, int item, int lane) {
    const int kblks = K >> 6; const int nb = item / kblks, kb = item - nb * kblks; const int k0 = 64 * kb, n0 = 32 * nb;
    const int nn = lane & 31; const int col = srcmap(mt, n0 + nn);
    float vals[32];
#pragma unroll
    for (int i = 0; i < 32; ++i) { const int kk = 2 * i + (lane >> 5); vals[i] = (col >= 0) ? W[(size_t)(k0 + kk) * Nsrc + col] : 0.f; }
    if (gain) {
#pragma unroll
        for (int i = 0; i < 32; ++i) vals[i] *= gain[k0 + 2 * i + (lane >> 5)]; }
#pragma unroll
    for (int i = 0; i < 32; ++i) scr[(2 * i + (lane >> 5)) * 33 + nn] = vals[i];
    LDS_WAIT();
    const int c = lane & 7;
#pragma unroll
    for (int j = 0; j < 4; ++j) { const int n = (lane >> 3) + 8 * j; const LAS float* s = scr + (8 * c) * 33 + n;
        u32x4 o; o.x = pk2(s[0 * 33], s[1 * 33]); o.y = pk2(s[2 * 33], s[3 * 33]); o.z = pk2(s[4 * 33], s[5 * 33]); o.w = pk2(s[6 * 33], s[7 * 33]);
        *(GAS u32x4*)(WT + (size_t)(n0 + n) * K + k0 + 8 * c) = o; }
    LDS_WAIT();
}
constexpr int CVT_ITEMS = 1920 + 1024 + 2816 + 1408 + 512 + 256 + 128 + 256 + 256 + 32 + 32;
DI void convert_layer(const Args& a, int l, bf16* wset, LAS float* scr, int first, int stride, int lane, int it_end = CVT_ITEMS) {
    for (int it = first; it < it_end; it += stride) {
        int r = it, mt, src, Nsrc, K; size_t loff, woff;
        if (r < 1920) { mt = 0; src = 2; Nsrc = D_IN; K = 1024; loff = (size_t)DM * D_IN; woff = W_IN; }
        else if ((r -= 1920) < 1024) { mt = 1; src = 2; Nsrc = D_IN; K = 1024; loff = (size_t)DM * D_IN; woff = W_G; }
        else if ((r -= 1024) < 2816) { mt = 2; src = 13; Nsrc = 2 * DFF; K = 1024; loff = (size_t)DM * 2 * DFF; woff = W_FF; }
        else if ((r -= 2816) < 1408) { mt = 3; src = 14; Nsrc = DM; K = DFF; loff = (size_t)DFF * DM; woff = W_FO; }
        else if ((r -= 1408) < 512) { mt = 4; src = 11; Nsrc = DM; K = 1024; loff = (size_t)DM * DM; woff = W_O; }
        else if ((r -= 512) < 256) { mt = 5; src = 9; Nsrc = DM; K = 512; loff = (size_t)512 * DM; woff = W_UA; }
        else if ((r -= 256) < 128) { mt = 6; src = 10; Nsrc = DM; K = 256; loff = (size_t)256 * DM; woff = W_UB; }
        else if ((r -= 128) < 256) { mt = 7; src = 5; Nsrc = 256; K = 2048; loff = (size_t)2048 * 256; woff = W_CK1; }
        else if ((r -= 256) < 256) { mt = 8; src = 7; Nsrc = 256; K = 2048; loff = (size_t)2048 * 256; woff = W_CV1; }
        else if ((r -= 256) < 32) { mt = 9; src = 6; Nsrc = 64; K = 256; loff = (size_t)256 * 64; woff = W_CK2; }
        else { r -= 32; mt = 10; src = 8; Nsrc = 64; K = 256; loff = (size_t)256 * 64; woff = W_CV2; }
        const float* gain = mt < 2 ? a.p[launder_i(1)] + (size_t)l * DM : (mt == 2 ? a.p[launder_i(12)] + (size_t)l * DM : nullptr);
        cvt_item(a.p[launder_i(src)] + (size_t)l * loff, Nsrc, K, gain, mt, wset + woff, scr, r, lane);
    }
}
DI void x_row_prep4(const float* xrow, bf16* orow, float* rs, int lane) {
    const GAS f32x4* xr = (const GAS f32x4*)xrow + lane; f32x4 v[16]; float s[4] = {0.f, 0.f, 0.f, 0.f};
#pragma unroll
    for (int j = 0; j < 16; ++j) v[j] = xr[64 * j];
#pragma unroll
    for (int j = 0; j < 16; ++j) s[j >> 2] += (v[j].x * v[j].x + v[j].y * v[j].y) + (v[j].z * v[j].z + v[j].w * v[j].w);
#pragma unroll
    for (int k = 0; k < 4; ++k) s[k] = wave_sum(s[k]);
    GAS u32x2* o8 = (GAS u32x2*)orow + lane;
#pragma unroll
    for (int j = 0; j < 16; ++j) { u32x2 w; w.x = pk2(v[j].x, v[j].y); w.y = pk2(v[j].z, v[j].w); o8[64 * j] = w; }
    const float sv = (lane >> 4) == 0 ? s[0] : ((lane >> 4) == 1 ? s[1] : ((lane >> 4) == 2 ? s[2] : s[3]));
    rs[lane] = (lane & 15) == 0 ? sv : 0.f;
}
DI void transpose_task(const bf16* PR, bf16* VT, int task, int lane) {
    const int pgrp = task & 127, b = (task >> 7) & 3, vi = task >> 9;
    const int cb = vi < 4 ? (vi < 2 ? 14 + vi : 16 + vi) : 40 + vi;
    const int dsh = vi < 8 ? 0 : (vi < 12 ? 2 : 4);
    const int Lsh = 13 - dsh;
    const int dg = lane & 7, pg = lane >> 3;
    const int p0 = 64 * pgrp + 8 * pg; const int r = p0 >> Lsh, i0 = p0 & ((1 << Lsh) - 1);
    const GAS bf16* src = (const GAS bf16*)PR + ((size_t)(cb * 4 + b) * SEQ + r) * 64 + 8 * dg;
    u32x4 R[8];
#pragma unroll
    for (int k = 0; k < 8; ++k) R[k] = *(const GAS u32x4*)(src + ((size_t)(i0 + k) << dsh) * 64);
    GAS bf16* dst = (GAS bf16*)VT + ((size_t)((vi * 4 + b) * 64 + 8 * dg)) * SEQ + p0;
    GAS bf16* dstf = (GAS bf16*)VT + ((size_t)(vi * 4 + b) * 64) * SEQ + (size_t)(p0 >> 5) * 2048;
    const int pgt = (p0 >> 3) & 3, s_ = pgt >> 1, half_ = pgt & 1;
#pragma unroll
    for (int j = 0; j < 8; ++j) {
        u32x4 o;
#pragma unroll
        for (int w = 0; w < 4; ++w) o[w] = __builtin_amdgcn_perm(R[2 * w + 1][j >> 1], R[2 * w][j >> 1], (j & 1) ? 0x07060302u : 0x05040100u);
        if (vi < 4) *(GAS u32x4*)(dst + (size_t)j * SEQ) = o;
        else { const int d = 8 * dg + j, d0 = d >> 5, dd = d & 31; GAS u32x2* q = (GAS u32x2*)(dstf + (size_t)((((s_ * 2 + d0) * 2 + half_) * 32 + dd) * 2) * 4);
            u32x2 a, c2; a.x = o.x; a.y = o.y; c2.x = o.z; c2.y = o.w; q[0] = a; q[1] = c2; }
    }
}

#define MFMA32(a, b, c) __builtin_amdgcn_mfma_f32_32x32x16_bf16((a), (b), (c), 0, 0, 0)
DI int crow(int r, int hi) { return (r & 3) + 8 * (r >> 2) + 4 * hi; }
struct KFrag { bf16x8 k[4]; };
struct VFrag { u32x2 v[8]; };
DI void load_k(KFrag& K, const bf16* Kb, int kstride, int r32, int hi) {
    const GAS bf16* p = (const GAS bf16*)Kb + (size_t)r32 * kstride + 8 * hi;
#pragma unroll
    for (int d0 = 0; d0 < 4; ++d0) K.k[d0] = *(const GAS bf16x8*)(p + 16 * d0);
}
DI void load_v(VFrag& V, const bf16* Vt, int vstride, int r32, int hi) {
#pragma unroll
    for (int s = 0; s < 2; ++s)
#pragma unroll
        for (int d0 = 0; d0 < 2; ++d0) {
            const GAS bf16* vp = (const GAS bf16*)Vt + (size_t)(r32 + 32 * d0) * vstride + 16 * s + 4 * hi;
            V.v[(2 * s + d0) * 2] = *(const GAS u32x2*)vp; V.v[(2 * s + d0) * 2 + 1] = *(const GAS u32x2*)(vp + 8);
        }
}
DI void load_kf(KFrag& K, const bf16* tile, int r32, int hi) {
    const GAS bf16* p = (const GAS bf16*)tile + (size_t)(r32 * 2 + hi) * 8;
#pragma unroll
    for (int d0 = 0; d0 < 4; ++d0) K.k[d0] = *(const GAS bf16x8*)(p + d0 * 512);
}
DI void load_vf(VFrag& V, const bf16* tile, int r32, int hi) {
#pragma unroll
    for (int s = 0; s < 2; ++s)
#pragma unroll
        for (int d0 = 0; d0 < 2; ++d0) {
            const GAS u32x2* p = (const GAS u32x2*)((const GAS bf16*)tile + (size_t)((((s * 2 + d0) * 2) * 32 + r32) * 2 + hi) * 4);
            V.v[(2 * s + d0) * 2] = p[0]; V.v[(2 * s + d0) * 2 + 1] = p[64];
        }
}

DI f32x16 qk_frag(const KFrag& K, const bf16x8 (&qf)[4]) {
    f32x16 s;
#pragma unroll
    for (int i = 0; i < 16; ++i) s[i] = 0.f;
#pragma unroll
    for (int d0 = 0; d0 < 4; ++d0) s = MFMA32(K.k[d0], qf[d0], s);
    return s;
}
DI void pv_frag(const VFrag& V, const f32x16& p, f32x16& o0, f32x16& o1) {
#pragma unroll
    for (int s = 0; s < 2; ++s) {
        u32x4 pw; pw.x = pk2(p[8 * s], p[8 * s + 1]); pw.y = pk2(p[8 * s + 2], p[8 * s + 3]); pw.z = pk2(p[8 * s + 4], p[8 * s + 5]); pw.w = pk2(p[8 * s + 6], p[8 * s + 7]);
        const bf16x8 pf = __builtin_bit_cast(bf16x8, pw);
#pragma unroll
        for (int d0 = 0; d0 < 2; ++d0) {
            const u32x2 lo = V.v[(2 * s + d0) * 2], h2 = V.v[(2 * s + d0) * 2 + 1];
            u32x4 vw; vw.x = lo.x; vw.y = lo.y; vw.z = h2.x; vw.w = h2.y;
            const bf16x8 vf = __builtin_bit_cast(bf16x8, vw);
            if (d0 == 0) o0 = MFMA32(vf, pf, o0); else o1 = MFMA32(vf, pf, o1);
        }
    }
}
DI float xhalf(float v) { const auto rr = __builtin_amdgcn_permlane32_swap(__float_as_uint(v), __float_as_uint(v), false, false); return (threadIdx.x & 32) ? __uint_as_float(rr[0]) : __uint_as_float(rr[1]); }
DI float xhalf_max(float v) { const auto rr = __builtin_amdgcn_permlane32_swap(__float_as_uint(v), __float_as_uint(v), false, false); return fmaxf(__uint_as_float(rr[0]), __uint_as_float(rr[1])); }
DI float xhalf_sum(float v) { const auto rr = __builtin_amdgcn_permlane32_swap(__float_as_uint(v), __float_as_uint(v), false, false); return __uint_as_float(rr[0]) + __uint_as_float(rr[1]); }
struct Flash { f32x16 o0, o1; float m, l; };
DI void flash_init(Flash& f) {
#pragma unroll
    for (int i = 0; i < 16; ++i) { f.o0[i] = 0.f; f.o1[i] = 0.f; }
    f.m = -1e20f; f.l = 0.f; }
DI void flash_step(Flash& f, f32x16& sc, const VFrag& V) {
    float mx = sc[0];
#pragma unroll
    for (int r = 1; r < 16; ++r) mx = fmaxf(mx, sc[r]);
    mx = xhalf_max(mx);
    const float mn = fmaxf(f.m, mx); const float alpha = fast_exp2(f.m - mn); f.m = mn;
    float ls = 0.f;
#pragma unroll
    for (int r = 0; r < 16; ++r) { sc[r] = fast_exp2(sc[r] - mn); ls += sc[r]; }
    f.l = f.l * alpha + ls;
    if (__builtin_amdgcn_ballot_w64(alpha != 1.f)) {
#pragma unroll
        for (int r = 0; r < 16; ++r) { f.o0[r] *= alpha; f.o1[r] *= alpha; }
    }
    pv_frag(V, sc, f.o0, f.o1);
}
constexpr int IMP_PITCH = 129;
constexpr int KB_BYTES = 64 * 144, VB_BYTES = 64 * 136, TBUF = KB_BYTES + VB_BYTES;
constexpr int LDS_SELM = 4 * 64 * IMP_PITCH * 4;
constexpr int LDS_INVL = LDS_SELM + 1024, LDS_CBUF = LDS_INVL + 1024, LDS_TB = 0;
static_assert(LDS_CBUF % 16 == 0 && TBUF % 16 == 0 && LDS_CBUF + TBUF <= LDS_BYTES - 64 && 2 * TBUF <= LDS_SELM, "attention LDS map");
struct StageRegs { u32x4 k, v; };
DI void stage_load(StageRegs& R, const bf16* Kb, int kstride, const bf16* Vt, int vstride, int tid, bool withV) {
    const int rw = tid >> 3, ch = tid & 7;
    R.k = *(const GAS u32x4*)((const GAS bf16*)Kb + (size_t)rw * kstride + ch * 8);
    if (withV) R.v = *(const GAS u32x4*)((const GAS bf16*)Vt + (size_t)rw * vstride + ch * 8);
}
DI void stage_store(LAS unsigned char* buf, const StageRegs& R, int tid, bool withV) {
    const int rw = tid >> 3, ch = tid & 7;
    *(LAS u32x4*)(buf + rw * 144 + ch * 16) = R.k;
    if (withV) { LAS u32x2* p = (LAS u32x2*)(buf + KB_BYTES + rw * 136 + ch * 16); u32x2 a, b2; a.x = R.v.x; a.y = R.v.y; b2.x = R.v.z; b2.y = R.v.w; p[0] = a; p[1] = b2; }
}
DI void lds_k(KFrag& K, const LAS unsigned char* buf, int sub, int r32, int hi) {
    const LAS unsigned char* p = buf + (32 * sub + r32) * 144 + 16 * hi;
#pragma unroll
    for (int d0 = 0; d0 < 4; ++d0) K.k[d0] = *(const LAS bf16x8*)(p + 32 * d0);
}
DI void lds_v(VFrag& V, const LAS unsigned char* buf, int sub, int r32, int hi) {
#pragma unroll
    for (int s = 0; s < 2; ++s)
#pragma unroll
        for (int d0 = 0; d0 < 2; ++d0) {
            const LAS unsigned char* p = buf + KB_BYTES + (r32 + 32 * d0) * 136 + (32 * sub + 16 * s + 4 * hi) * 2;
            V.v[(2 * s + d0) * 2] = *(const LAS u32x2*)p; V.v[(2 * s + d0) * 2 + 1] = *(const LAS u32x2*)(p + 16);
        }
}

struct Soft { f32x16 o0, o1; float mref, l; bool seen; };
DI void soft_init(Soft& f) {
#pragma unroll
    for (int i = 0; i < 16; ++i) { f.o0[i] = 0.f; f.o1[i] = 0.f; }
    f.mref = 0.f; f.l = 0.f; f.seen = false; }
DI int ccol(int r) { return (r & 3) + 8 * (r >> 2); }
DI void tile_scores(f32x16& x0, f32x16& x1, const LAS unsigned char* buf, const bf16x8 (&qf)[4], float sk, float aref, int p0, bool laneok, bool needmask, int lo, int hip, int r32, int hi) {
    KFrag K0, K1; lds_k(K0, buf, 0, r32, hi); lds_k(K1, buf, 1, r32, hi);
    const float B = laneok ? fmaf(sk, (float)(p0 + 4 * hi), -aref) : -1e30f;
    const float B1 = B + 32.f * sk;
#pragma unroll
    for (int r = 0; r < 16; ++r) { x0[r] = fmaf(sk, (float)ccol(r), B); x1[r] = fmaf(sk, (float)ccol(r), B1); }
#pragma unroll
    for (int d0 = 0; d0 < 4; ++d0) { x0 = MFMA32(K0.k[d0], qf[d0], x0); x1 = MFMA32(K1.k[d0], qf[d0], x1); }
    if (needmask) {
#pragma unroll
        for (int r = 0; r < 16; ++r) { const int pos = p0 + crow(r, hi); if (pos < lo || pos > hip) x0[r] = -1e30f; if (pos + 32 < lo || pos + 32 > hip) x1[r] = -1e30f; }
    }
}
DI float soft_update(Soft& f, f32x16& x0, f32x16& x1, bool hasO) {
    float mx = fmaxf(x0[0], x1[0]);
#pragma unroll
    for (int r = 1; r < 16; ++r) mx = fmaxf(mx, fmaxf(x0[r], x1[r]));
    mx = xhalf_max(mx);
    const bool valid = mx > -1e20f;
    const bool need = valid && (mx > 8.f || !f.seen);
    float dmove = 0.f;
    if (__builtin_amdgcn_ballot_w64(need)) {
        const float delta = need ? fmaxf(mx, -60.f) : 0.f; const float sc = fast_exp2(-delta);
        dmove = delta;
        f.mref += delta; f.l *= sc;
        if (hasO) {
#pragma unroll
            for (int r = 0; r < 16; ++r) { f.o0[r] *= sc; f.o1[r] *= sc; } }
#pragma unroll
        for (int r = 0; r < 16; ++r) { x0[r] -= delta; x1[r] -= delta; }
    }
    f.seen = f.seen || valid;
    float ls = 0.f;
#pragma unroll
    for (int r = 0; r < 16; ++r) { x0[r] = fast_exp2(x0[r]); x1[r] = fast_exp2(x1[r]); ls += x0[r] + x1[r]; }
    f.l += ls;
    return dmove;
}
DI void tile_pv(Soft& f, const LAS unsigned char* buf, const f32x16& p0v, const f32x16& p1v, int r32, int hi) {
    VFrag V0, V1; lds_v(V0, buf, 0, r32, hi); lds_v(V1, buf, 1, r32, hi);
    pv_frag(V0, p0v, f.o0, f.o1); pv_frag(V1, p1v, f.o0, f.o1);
}
DI void tile_pv2(Soft& f, const VFrag& V0, const VFrag& V1, const f32x16& p0v, const f32x16& p1v) { pv_frag(V0, p0v, f.o0, f.o1); pv_frag(V1, p1v, f.o0, f.o1); }

DI void frag_scores(f32x16& x0, const KFrag& K0, const bf16x8 (&qf)[4], float sk, float aref, int p0, bool needmask, int lo, int hip, int hi) {
    const float B = fmaf(sk, (float)(p0 + 4 * hi), -aref);
#pragma unroll
    for (int r = 0; r < 16; ++r) x0[r] = fmaf(sk, (float)ccol(r), B);
#pragma unroll
    for (int d0 = 0; d0 < 4; ++d0) x0 = MFMA32(K0.k[d0], qf[d0], x0);
    if (needmask) {
#pragma unroll
        for (int r = 0; r < 16; ++r) { const int pos = p0 + crow(r, hi); if (pos < lo || pos > hip) x0[r] = -1e30f; }
    }
}
DI void soft_update1(Soft& f, f32x16& x0) {
    float mx = x0[0];
#pragma unroll
    for (int r = 1; r < 16; ++r) mx = fmaxf(mx, x0[r]);
    mx = xhalf_max(mx);
    const bool valid = mx > -1e20f;
    const bool need = valid && (mx > 8.f || !f.seen);
    if (__builtin_amdgcn_ballot_w64(need)) {
        const float delta = need ? fmaxf(mx, -60.f) : 0.f; const float sc = fast_exp2(-delta);
        f.mref += delta; f.l *= sc;
#pragma unroll
        for (int r = 0; r < 16; ++r) { f.o0[r] *= sc; f.o1[r] *= sc; x0[r] -= delta; }
    }
    f.seen = f.seen || valid;
    float ls = 0.f;
#pragma unroll
    for (int r = 0; r < 16; ++r) { x0[r] = fast_exp2(x0[r]); ls += x0[r]; }
    f.l += ls;
}

DI void nsa_unit(const bf16* PR, const bf16* VT, const bf16* kcb, const bf16* vctb, bf16* Y, LAS unsigned char* lds, int b, int g, int jt) {
    const int tid = pg8::pg8_tid(), lane = tid & 63, r32 = lane & 31, hi = lane >> 5, wid = __builtin_amdgcn_readfirstlane(tid >> 6);
    const int hq = wid & 3, th = wid >> 2, h = 4 * g + hq;
    const int tl = 32 * th + r32, t = 64 * jt + tl; const size_t row = (size_t)b * SEQ + t;
    const int tw0 = 64 * jt + 32 * th;
    const float slope2 = exp2f(-0.4f * (float)(9 + h)) * LOG2E;
    bf16x8 qf[4];
    { const GAS bf16* qp = (const GAS bf16*)PR + ((size_t)h * NTOK + row) * 64 + 8 * hi;
#pragma unroll
      for (int d0 = 0; d0 < 4; ++d0) qf[d0] = *(const GAS bf16x8*)(qp + 16 * d0); }
    float g0, g1, g2;
    { const GAS bf16* gp = (const GAS bf16*)PR + ((size_t)56 * NTOK + row) * 64 + h * 3; g0 = bf2f(gp[0]); g1 = bf2f(gp[1]); g2 = bf2f(gp[2]); }
    LAS float* imp = (LAS float*)lds; LAS unsigned* selm = (LAS unsigned*)(lds + LDS_SELM); LAS float* invl = (LAS float*)(lds + LDS_INVL); LAS unsigned char* tb = lds + LDS_TB;
    { LAS float* zr = imp + (size_t)(tid >> 1) * IMP_PITCH;
      for (int j = tid & 1; j <= jt; j += 2) zr[j] = 0.f; }
    f32x16 acc0, acc1;
    StageRegs R;
    {
        const bf16* kc = kcb + (size_t)(g * 4 + b) * 512 * 64; const bf16* vct = vctb + (size_t)(g * 4 + b) * 64 * 512;
        const int nq = (t >= 31) ? ((t - 31) >> 4) : -1;
        const int nhi_w = 4 * jt + 2 * th;
        const int nqmin = (tw0 >= 31) ? ((tw0 - 31) >> 4) : -1;
        const int ncmp = ((4 * jt + 2) >> 6) + 1;
        const float sk = 16.f * slope2, ab = slope2 * (float)(t - 31);
        Soft f; soft_init(f);
        LAS unsigned char* cbuf = lds + LDS_CBUF;
        LAS float* impw = imp + ((size_t)hq * 64 + tl) * IMP_PITCH;
        stage_load(R, kc + (size_t)(ncmp - 1) * 64 * 64, 64, vct + 64 * (ncmp - 1), 512, tid, true); stage_store(cbuf, R, tid, true); __syncthreads();
        for (int i = ncmp - 1; i >= 0; --i) {
            if (i > 0) stage_load(R, kc + (size_t)(i - 1) * 64 * 64, 64, vct + 64 * (i - 1), 512, tid, true);
            if (64 * i <= nhi_w) {
                VFrag V0, V1; lds_v(V0, cbuf, 0, r32, hi); lds_v(V1, cbuf, 1, r32, hi);
                f32x16 x0, x1; tile_scores(x0, x1, cbuf, qf, sk, ab + f.mref, 64 * i, true, 64 * i + 63 > nqmin, -(1 << 30), nq, r32, hi);
                const bool had = f.seen;
                const float dl = soft_update(f, x0, x1, true);
                if (__builtin_amdgcn_ballot_w64(had && dl != 0.f)) {
                    const float sc = (had && dl != 0.f) ? fast_exp2(-dl) : 1.f;
                    for (int j = hi; j < 128; j += 2) impw[j] *= sc;
                }
#pragma unroll
                for (int a = 0; a < 4; ++a) { const int j = 16 * i + 2 * a + hi; const float h3 = 0.5f * x0[4 * a + 3], h3b = 0.5f * x1[4 * a + 3];
                    __hip_atomic_fetch_add(impw + j, (x0[4 * a] + x0[4 * a + 1]) + (x0[4 * a + 2] + h3), __ATOMIC_RELAXED, __HIP_MEMORY_SCOPE_WORKGROUP);
                    __hip_atomic_fetch_add(impw + j + 1, h3, __ATOMIC_RELAXED, __HIP_MEMORY_SCOPE_WORKGROUP);
                    __hip_atomic_fetch_add(impw + j + 8, (x1[4 * a] + x1[4 * a + 1]) + (x1[4 * a + 2] + h3b), __ATOMIC_RELAXED, __HIP_MEMORY_SCOPE_WORKGROUP);
                    if (j + 9 <= 127) __hip_atomic_fetch_add(impw + j + 9, h3b, __ATOMIC_RELAXED, __HIP_MEMORY_SCOPE_WORKGROUP); }
                tile_pv2(f, V0, V1, x0, x1);
            }
            __syncthreads();
            if (i > 0) { stage_store(cbuf, R, tid, true); __syncthreads(); }
        }
        const float l = xhalf_sum(f.l);
        const float inv_l = l > 0.f ? 1.f / l : 0.f;
        if (hi == 0) invl[hq * 64 + tl] = inv_l;
        const float gs = g0 * inv_l;
#pragma unroll
        for (int i = 0; i < 16; ++i) { acc0[i] = gs * f.o0[i]; acc1[i] = gs * f.o1[i]; }
    }
    __syncthreads();
    {
        const int tok = 8 * wid + (lane >> 3), sub = lane & 7;
        float v[16]; unsigned selbits = 0u;
#pragma unroll
        for (int k = 0; k < 16; ++k) { const int j = 16 * sub + k;
            const bool valid = j <= jt, forced = (j == 0) || (j == jt) || (j == jt - 1);
            float s = -1.f;
            if (valid && !forced) s = (imp[((size_t)0 * 64 + tok) * IMP_PITCH + j] * invl[0 * 64 + tok] + imp[((size_t)1 * 64 + tok) * IMP_PITCH + j] * invl[1 * 64 + tok])
                                    + (imp[((size_t)2 * 64 + tok) * IMP_PITCH + j] * invl[2 * 64 + tok] + imp[((size_t)3 * 64 + tok) * IMP_PITCH + j] * invl[3 * 64 + tok]);
            if (valid && (forced || jt < 16)) selbits |= 1u << k;
            v[k] = s; }
        if (jt >= 16) {
            for (int round = 0; round < 13; ++round) {
                float bv = -1.f; int bj = 1 << 20;
#pragma unroll
                for (int k = 0; k < 16; ++k) { if (v[k] > bv) { bv = v[k]; bj = 16 * sub + k; } }
#define SEL_DPP_STEP(ctrl_) do { const float ov = __uint_as_float((unsigned)__builtin_amdgcn_mov_dpp((int)__float_as_uint(bv), ctrl_, 0xf, 0xf, true)); const int oj = __builtin_amdgcn_mov_dpp(bj, ctrl_, 0xf, 0xf, true); \
                    if (ov > bv || (ov == bv && oj < bj)) { bv = ov; bj = oj; } } while (0)
                SEL_DPP_STEP(0xB1); SEL_DPP_STEP(0x4E); SEL_DPP_STEP(0x141);
#undef SEL_DPP_STEP
                if ((bj >> 4) == sub) {
#pragma unroll
                    for (int k = 0; k < 16; ++k) if (k == (bj & 15)) { v[k] = -1.f; selbits |= 1u << k; }
                }
            }
        }
        ((LAS unsigned short*)selm)[tok * 8 + sub] = (unsigned short)selbits;
    }
    __syncthreads();
    {
        unsigned mk0, mk1, mk2, mk3, wu0, wu1, wu2, wu3, gu0, gu1, gu2, gu3;
        { unsigned mk[4], wu[4], gu[4];
#pragma unroll
          for (int w = 0; w < 4; ++w) { mk[w] = selm[tl * 4 + w]; unsigned u = mk[w];
#pragma unroll
              for (int off = 1; off < 32; off <<= 1) u |= (unsigned)__shfl_xor((int)u, off);
              wu[w] = __builtin_amdgcn_readfirstlane(u);
              unsigned u2 = selm[lane * 4 + w];
#pragma unroll
              for (int off = 1; off < 64; off <<= 1) u2 |= (unsigned)__shfl_xor((int)u2, off);
              gu[w] = __builtin_amdgcn_readfirstlane(u2); }
          mk0 = mk[0]; mk1 = mk[1]; mk2 = mk[2]; mk3 = mk[3]; wu0 = wu[0]; wu1 = wu[1]; wu2 = wu[2]; wu3 = wu[3]; gu0 = gu[0]; gu1 = gu[1]; gu2 = gu[2]; gu3 = gu[3]; }
        Soft f; soft_init(f);
        const bf16* ks = PR + ((size_t)(12 + g) * NTOK + (size_t)b * SEQ) * 64; const bf16* vst = VT + ((size_t)(g * 4 + b) * 64) * SEQ;
        const float ab = slope2 * (float)t;
        int itw = 3; unsigned itbits = gu3;
#define SEL_NEXT(j_) do { j_ = -1; while (itbits == 0u && itw > 0) { --itw; itbits = itw == 2 ? gu2 : (itw == 1 ? gu1 : gu0); } \
            if (itbits != 0u) { const int jb_ = 31 - __builtin_clz(itbits); itbits &= ~(1u << jb_); j_ = 32 * itw + jb_; } } while (0)
        int jcur; SEL_NEXT(jcur);
        stage_load(R, ks + (size_t)jcur * 64 * 64, 64, vst + 64 * jcur, SEQ, tid, true); stage_store(tb, R, tid, true); __syncthreads();
        int par = 0;
        while (jcur >= 0) {
            int jnext; SEL_NEXT(jnext);
            if (jnext >= 0) stage_load(R, ks + (size_t)jnext * 64 * 64, 64, vst + 64 * jnext, SEQ, tid, true);
            const LAS unsigned char* buf = tb + par * TBUF;
            const int jw = jcur >> 5, jb = jcur & 31;
            const unsigned wuw = jw == 0 ? wu0 : (jw == 1 ? wu1 : (jw == 2 ? wu2 : wu3));
            if ((wuw >> jb) & 1u) {
                const unsigned mw = jw == 0 ? mk0 : (jw == 1 ? mk1 : (jw == 2 ? mk2 : mk3));
                const bool mysel = (mw >> jb) & 1u;
                VFrag V0, V1; lds_v(V0, buf, 0, r32, hi); lds_v(V1, buf, 1, r32, hi);
                f32x16 x0, x1; tile_scores(x0, x1, buf, qf, slope2, ab + f.mref, 64 * jcur, mysel, jcur == jt, -(1 << 30), t, r32, hi);
                soft_update(f, x0, x1, true);
                tile_pv2(f, V0, V1, x0, x1);
            }
            if (jnext >= 0) stage_store(tb + (par ^ 1) * TBUF, R, tid, true);
            __syncthreads();
            par ^= 1; jcur = jnext;
        }
#undef SEL_NEXT
        const float l = xhalf_sum(f.l); const float sc_ = l > 0.f ? g1 / l : 0.f;
#pragma unroll
        for (int i = 0; i < 16; ++i) { acc0[i] += sc_ * f.o0[i]; acc1[i] += sc_ * f.o1[i]; }
    }
    {
        Soft f; soft_init(f);
        const bf16* kw = PR + ((size_t)(16 + g) * NTOK + (size_t)b * SEQ) * 64; const bf16* vwt = VT + ((size_t)((2 + g) * 4 + b) * 64) * SEQ;
        const float ab = slope2 * (float)t;
        const int kfirst = jt >= 8 ? 64 * (jt - 8) : 0, klast = 64 * jt;
        stage_load(R, kw + (size_t)klast * 64, 64, vwt + klast, SEQ, tid, true); stage_store(tb, R, tid, true); __syncthreads();
        int par = 0;
        for (int kt = klast; kt >= kfirst; kt -= 64) {
            if (kt - 64 >= kfirst) stage_load(R, kw + (size_t)(kt - 64) * 64, 64, vwt + kt - 64, SEQ, tid, true);
            const LAS unsigned char* buf = tb + par * TBUF;
            if (kt + 63 >= tw0 - 511) {
                const bool needmask = (kt + 63 > tw0) || (kt < tw0 + 31 - 511);
                VFrag V0, V1; lds_v(V0, buf, 0, r32, hi); lds_v(V1, buf, 1, r32, hi);
                f32x16 x0, x1; tile_scores(x0, x1, buf, qf, slope2, ab + f.mref, kt, true, needmask, t - 511, t, r32, hi);
                soft_update(f, x0, x1, true);
                tile_pv2(f, V0, V1, x0, x1);
            }
            if (kt - 64 >= kfirst) stage_store(tb + (par ^ 1) * TBUF, R, tid, true);
            __syncthreads();
            par ^= 1;
        }
        const float l = xhalf_sum(f.l); const float sc_ = l > 0.f ? g2 / l : 0.f;
#pragma unroll
        for (int i = 0; i < 16; ++i) { acc0[i] += sc_ * f.o0[i]; acc1[i] += sc_ * f.o1[i]; }
    }
    { GAS bf16* yp = (GAS bf16*)Y + row * 768 + h * 64 + 4 * hi;
#pragma unroll
      for (int a = 0; a < 4; ++a) {
          u32x2 w0; w0.x = pk2(acc0[4 * a], acc0[4 * a + 1]); w0.y = pk2(acc0[4 * a + 2], acc0[4 * a + 3]); *(GAS u32x2*)(yp + 8 * a) = w0;
          u32x2 w1; w1.x = pk2(acc1[4 * a], acc1[4 * a + 1]); w1.y = pk2(acc1[4 * a + 2], acc1[4 * a + 3]); *(GAS u32x2*)(yp + 32 + 8 * a) = w1; } }
}

constexpr int DIL_YOFF = 4096, DIL_YPITCH = 136;
static_assert(DIL_YOFF + 512 * DIL_YPITCH <= LDS_BYTES - 64, "dilated-unit LDS map");
DI void dil_unit(const bf16* PR, const bf16* VT, bf16* Y, LAS unsigned char* lds, int b, int hh, int tb) {
    const int tid = pg8::pg8_tid(), lane = tid & 63, r32 = lane & 31, hi = lane >> 5, wid = __builtin_amdgcn_readfirstlane(tid >> 6);
    LAS float* lser = (LAS float*)lds; LAS unsigned char* yl = lds + DIL_YOFF;
    for (int gidx = 0; gidx < 3; ++gidx) {
        const int dsh = 2 * gidx, dil = 1 << dsh, nsub = 16 >> dsh, L = SEQ >> dsh;
        const int kidx = gidx < 2 ? 1 + 4 * gidx + hh : 17 + hh;
        const float slope2d = exp2f(-0.4f * (float)kidx) * LOG2E * (float)dil;
        for (int wt = wid; wt < 16; wt += 8) {
            const int r = wt / nsub, sb = wt - r * nsub; const int i0 = ((512 * tb) >> dsh) + 32 * sb; const int i = i0 + r32; const int t = r + (i << dsh);
            const size_t row = (size_t)b * SEQ + t;
            bf16x8 qf[4];
            { const GAS bf16* qp = (const GAS bf16*)PR + ((size_t)(20 + gidx * 4 + hh) * NTOK + row) * 64 + 8 * hi;
#pragma unroll
              for (int d0 = 0; d0 < 4; ++d0) qf[d0] = *(const GAS bf16x8*)(qp + 16 * d0); }
            const bf16* kpl = PR + ((size_t)(32 + gidx * 4 + hh) * NTOK + (size_t)b * SEQ) * 64;
            const bf16* vpl = VT + ((size_t)(((4 + gidx * 4 + hh) * 4 + b) * 64)) * SEQ; const int pr = r * L;
            Soft f; soft_init(f);
            const int ipf = i0 - 128 < 0 ? 0 : i0 - 128;
            const float ab = slope2d * (float)i;
            KFrag Kq[3]; VFrag Vq[3];
#define DIL_LOAD(slot, s_) do { const int ip_ = i0 - 32 * (s_) >= ipf ? i0 - 32 * (s_) : ipf; const size_t to_ = (size_t)((pr + ip_) >> 5) * 2048; load_kf(Kq[slot], kpl + to_, r32, hi); load_vf(Vq[slot], vpl + to_, r32, hi); } while (0)
            DIL_LOAD(0, 0); DIL_LOAD(1, 1);
#pragma unroll
            for (int s = 0; s < 5; ++s) {
                if (s + 2 < 5) DIL_LOAD((s + 2) % 3, s + 2);
                const int ip0 = i0 - 32 * s;
                if (ip0 >= ipf) {
                    f32x16 x; frag_scores(x, Kq[s % 3], qf, slope2d, ab + f.mref, ip0, s == 0 || s == 4, i - 128, i, hi);
                    soft_update1(f, x);
                    pv_frag(Vq[s % 3], x, f.o0, f.o1);
                }
            }
#undef DIL_LOAD
            const float l = xhalf_sum(f.l); const float inv = 1.f / l; const float lse2 = f.mref + __builtin_amdgcn_logf(l);
            const int tloc = t - 512 * tb;
            LAS unsigned char* yp = yl + tloc * DIL_YPITCH + 8 * hi;
            float wa = 0.f, wb = inv, lnew = lse2;
            if (gidx > 0) { const float Lr = lser[tloc]; const float M = fmaxf(Lr, lse2); const float ea = fast_exp2(Lr - M), eb = fast_exp2(lse2 - M); const float den = 1.f / (ea + eb);
                wa = ea * den; wb = eb * den * inv; lnew = M + __builtin_amdgcn_logf(ea + eb); }
#pragma unroll
            for (int a = 0; a < 4; ++a)
#pragma unroll
                for (int d0 = 0; d0 < 2; ++d0) {
                    LAS u32x2* p = (LAS u32x2*)(yp + 64 * d0 + 16 * a);
                    float o[4];
#pragma unroll
                    for (int k = 0; k < 4; ++k) o[k] = wb * (d0 ? f.o1[4 * a + k] : f.o0[4 * a + k]);
                    if (gidx > 0) { const u32x2 y = *p; o[0] += wa * __uint_as_float(y.x << 16); o[1] += wa * __uint_as_float(y.x & 0xffff0000u); o[2] += wa * __uint_as_float(y.y << 16); o[3] += wa * __uint_as_float(y.y & 0xffff0000u); }
                    u32x2 w; w.x = pk2(o[0], o[1]); w.y = pk2(o[2], o[3]); *p = w;
                }
            if (hi == 0) lser[tloc] = lnew;
        }
        __syncthreads();
    }
    { const size_t rowb = (size_t)b * SEQ + 512 * tb;
#pragma unroll
      for (int k = 0; k < 8; ++k) { const int tok = (tid >> 3) + 64 * k, ch = tid & 7;
          const LAS u32x2* p = (const LAS u32x2*)(yl + tok * DIL_YPITCH + ch * 16); const u32x2 a = p[0], c2 = p[1];
          u32x4 w; w.x = a.x; w.y = a.y; w.z = c2.x; w.w = c2.y;
          *(GAS u32x4*)((GAS bf16*)Y + (rowb + tok) * 768 + 512 + hh * 64 + ch * 8) = w; } }
    __syncthreads();
}
#ifndef REP_PRO
#define REP_PRO 1
#endif
constexpr int CVT_SPLIT = 5120;
#ifndef REP_P1
#define REP_P1 1
#endif
#ifndef REP_P2
#define REP_P2 1
#endif
#ifndef REP_P3
#define REP_P3 1
#endif
#ifndef REP_P4
#define REP_P4 1
#endif
#ifndef REP_P6
#define REP_P6 1
#endif
#ifndef REP_SYNC
#define REP_SYNC 0
#endif
#ifndef REP_NSA
#define REP_NSA 1
#endif
#ifndef REP_DIL
#define REP_DIL 1
#endif
#define GEMM_PHASE(EpiT, SchedT, g, S, E) pg8::gemm_phase<EpiT, SchedT, true, true>(ldsl, g, S, E)
#define PHASE_HEAD const int G = launder_i((int)gridDim.x), c = launder_i((int)blockIdx.x); unsigned char* ws = (unsigned char*)a.p[launder_i(17)]; (void)G; (void)c; \
    const int tid = pg8::pg8_tid(), lane = tid & 63, wid = __builtin_amdgcn_readfirstlane(tid >> 6); (void)lane; (void)wid; \
    bf16* wset = (bf16*)(ws + ((l & 1) ? WS_W1 : WS_W0)); (void)wset; float* rsum = (float*)(ws + WS_RSUM); (void)rsum; bf16* xb = (bf16*)(ws + WS_XB); (void)xb; bf16* PR = (bf16*)(ws + WS_PR); (void)PR;

DI void phase_prologue(const Args& a, LAS unsigned char* ldsl) { const int l = 0; PHASE_HEAD
    const int gw = c * 8 + wid, NGW = G * 8; float* bias1 = (float*)(ws + WS_BIAS);
    LAS float* scr = (LAS float*)(ldsl + wid * 16384);
    convert_layer(a, 0, (bf16*)(ws + WS_W0), scr, gw, NGW, lane, 1920);
    convert_layer(a, 0, (bf16*)(ws + WS_W0), scr, 8064 + gw, NGW, lane, CVT_ITEMS);
    for (int row = 4 * gw; row < NTOK; row += 4 * NGW) x_row_prep4(a.p[launder_i(0)] + (size_t)row * DM, xb + (size_t)row * DM, rsum + (size_t)row * 16, lane);
    for (int task = gw; task < DEPTH * 2 * 256; task += NGW) {
        const int col = task & 255, kv = (task >> 8) & 1, ll = task >> 9;
        const float* pe = a.p[launder_i(kv ? 4 : 3)] + (size_t)ll * 2048; const float* w1 = a.p[launder_i(kv ? 7 : 5)] + (size_t)ll * 2048 * 256;
        float s = 0.f; float wv[32];
#pragma unroll
        for (int i = 0; i < 32; ++i) wv[i] = w1[(size_t)(lane + 64 * i) * 256 + col];
#pragma unroll
        for (int i = 0; i < 32; ++i) s += pe[lane + 64 * i] * wv[i];
        s = wave_sum(s);
        if (lane == 0) bias1[task] = s;
    }
}
DI void phase_inproj(const Args& a, LAS unsigned char* ldsl, int l) { PHASE_HEAD
    Gemm g{xb, wset + W_IN, NTOK, 3584, 1024, 1024, 1024}; pg8::StaticOrder S; S.init(NTOK, 3584, G, c); EpiProj E{PR, rsum, (LAS float*)(ldsl + 131072)};
    GEMM_PHASE(EpiProj, pg8::StaticOrder, g, S, E); }
DI void phase_compress_a(const Args& a, LAS unsigned char* ldsl, int l) { PHASE_HEAD
    bf16* VT = (bf16*)(ws + WS_VT); float* part = (float*)(ws + WS_PART);
    if (c < 64) {
        const int kv = c >> 5, kh = (c >> 4) & 1, pm = c & 15;
        Gemm g{PR + (size_t)(8 + 2 * kv) * NTOK * 64 + kh * 1024, wset + (kv ? W_CV1 : W_CK1) + kh * 1024, 4096, 256, 1024, 1024, 2048}; OneUnit S{pm, 0, 1};
        EpiF32 E{part + (size_t)(kv * 2 + kh) * 4096 * 256, 256};
        GEMM_PHASE(EpiF32, OneUnit, g, S, E);
    } else {
        { Gemm g{xb, wset + W_IN + (size_t)3584 * 1024, NTOK, 256, 1024, 1024, 1024}; OneUnit S{c - 64, 0, (c - 64) < NTOK / 256 ? 1 : 0}; EpiGa E{PR, rsum};
          GEMM_PHASE(EpiGa, OneUnit, g, S, E); }
        if (c >= 192) { for (int task = (c - 192) * 8 + wid; task < 5888; task += 2 * 64 * 8) { transpose_task(PR, VT, task, lane); if (task + 64 * 8 < 5888) transpose_task(PR, VT, task + 64 * 8, lane); } }
        else { for (int task = 5888 + (c - 64) * 8 + wid; task < 16 * 4 * 128; task += 128 * 8) transpose_task(PR, VT, task, lane); }
    } }
DI void phase_attn(const Args& a, LAS unsigned char* ldsl, int l) { PHASE_HEAD
    float* bias1 = (float*)(ws + WS_BIAS); bf16* kcb = (bf16*)(ws + WS_KC); bf16* vctb = (bf16*)(ws + WS_VCT); bf16* Hb = (bf16*)(ws + WS_H); const float* part = (const float*)(ws + WS_PART);
    bf16* VT = (bf16*)(ws + WS_VT); bf16* Y = (bf16*)(ws + WS_Y);
    unsigned* flag = (unsigned*)ws + XCD_BAR_WORDS + 64 * (32 + l);
    if (c < 32) {
        const int kv = c >> 4, pm = c & 15;
        { const GAS f32x4* p0 = (const GAS f32x4*)(part + (size_t)(kv * 2) * 4096 * 256 + (size_t)pm * 256 * 256); const GAS f32x4* p1 = p0 + (size_t)4096 * 256 / 4;
          const GAS f32x4* bs = (const GAS f32x4*)(bias1 + (size_t)(l * 2 + kv) * 256); GAS u32x2* ho = (GAS u32x2*)(Hb + (size_t)kv * 4096 * 256 + (size_t)pm * 256 * 256);
          const f32x4 bv = bs[tid & 63];
          for (int i0 = tid; i0 < 256 * 256 / 4; i0 += 512 * 8) {
              f32x4 va[8], vb[8];
#pragma unroll
              for (int k = 0; k < 8; ++k) { va[k] = p0[i0 + 512 * k]; vb[k] = p1[i0 + 512 * k]; }
#pragma unroll
              for (int k = 0; k < 8; ++k) { const f32x4 v = va[k] + vb[k] + bv;
                  u32x2 w; w.x = pk2(siluf_(v[0]), siluf_(v[1])); w.y = pk2(siluf_(v[2]), siluf_(v[3])); ho[i0 + 512 * k] = w; } } }
        __builtin_amdgcn_fence(__ATOMIC_RELEASE, "workgroup"); __syncthreads(); __builtin_amdgcn_fence(__ATOMIC_ACQUIRE, "workgroup");
        { Gemm g{Hb + (size_t)kv * 4096 * 256, wset + (kv ? W_CV2 : W_CK2), 4096, 256, 256, 256, 256}; OneUnit S{pm, 0, 1};
          EpiCmp E{kv ? vctb : kcb, kv};
          GEMM_PHASE(EpiCmp, OneUnit, g, S, E); }
        asm volatile("s_waitcnt vmcnt(0)" ::: "memory");
        __syncthreads();
        if (tid == 0) { __builtin_amdgcn_fence(__ATOMIC_RELEASE, "agent"); asm volatile("s_waitcnt vmcnt(0)" ::: "memory");
            (void)__hip_atomic_fetch_add(flag, 1u, __ATOMIC_RELAXED, __HIP_MEMORY_SCOPE_AGENT); }
    }
    const int xq = c & 7;
    unsigned* ctr = (unsigned*)ws + XCD_BAR_WORDS + 64 * (8 * l + xq);
    volatile LAS int* qslot = (volatile LAS int*)(ldsl + LDS_BYTES - 32);
    const int nitems = 160 + ((l + 1 < DEPTH) ? 16 : 0) + (l == 0 ? 16 : 0);
    bool kc_ready = false;
    for (;;) {
        if (tid == 0) *qslot = (int)__hip_atomic_fetch_add(ctr, 1u, __ATOMIC_RELAXED, __HIP_MEMORY_SCOPE_AGENT);
        __syncthreads();
        const int q = __builtin_amdgcn_readfirstlane(*qslot);
        __syncthreads();
        if (q >= nitems) break;
        if (q < 32) { const int pl = 2 * xq + (q >> 4); dil_unit(PR, VT, Y, ldsl, pl >> 2, pl & 3, q & 15); }
        else if (q < 160) {
            if (!kc_ready) {
                if (tid == 0) { unsigned sp = 0u;
                    while (__hip_atomic_load(flag, __ATOMIC_RELAXED, __HIP_MEMORY_SCOPE_AGENT) < 32u) { __builtin_amdgcn_s_sleep(1); if (++sp > (1u << 24)) break; }
                    __builtin_amdgcn_fence(__ATOMIC_ACQUIRE, "agent"); asm volatile("s_waitcnt vmcnt(0)" ::: "memory"); }
                __syncthreads();
                kc_ready = true;
            }
            nsa_unit(PR, VT, kcb, vctb, Y, ldsl, xq >> 1, xq & 1, 159 - q);
        } else if (l == 0 && q >= 176) {
            const int gch = xq * 16 + (q - 176); const int i0 = 1920 + gch * 48, i1 = i0 + 48 < 8064 ? i0 + 48 : 8064;
            LAS float* scr = (LAS float*)(ldsl + wid * 16384);
            convert_layer(a, 0, (bf16*)(ws + WS_W0), scr, i0 + wid, 8, lane, i1);
            __syncthreads();
        } else {
            const int gch = xq * 16 + (q - 160); const int i0 = gch * 68, i1 = i0 + 68 < CVT_ITEMS ? i0 + 68 : CVT_ITEMS;
            LAS float* scr = (LAS float*)(ldsl + wid * 16384);
            convert_layer(a, l + 1, (bf16*)(ws + (((l + 1) & 1) ? WS_W1 : WS_W0)), scr, i0 + wid, 8, lane, i1);
            __syncthreads();
        }
    } }
DI void phase_merge(const Args& a, LAS unsigned char* ldsl, int l) { PHASE_HEAD
    bf16* Y = (bf16*)(ws + WS_Y); bf16* Ta = (bf16*)(ws + WS_TA); bf16* Tb = (bf16*)(ws + WS_TB); bf16* MG = (bf16*)(ws + WS_MG);
    { Gemm g{Y, wset + W_UA, NTOK, 1024, 512, 768, 512}; PanelOrder S{2, G, c}; EpiBf<0> E{Ta, DM, nullptr}; GEMM_PHASE(EpiBf<0>, PanelOrder, g, S, E); }
    { Gemm g{Y + 512, wset + W_UB, NTOK, 1024, 256, 768, 256}; PanelOrder S{2, G, c}; EpiBf<0> E{Tb, DM, nullptr}; GEMM_PHASE(EpiBf<0>, PanelOrder, g, S, E); }
    { Gemm g{xb, wset + W_G, NTOK, 2048, 1024, 1024, 1024}; PanelOrder S{4, G, c}; EpiGate E{Ta, Tb, MG, rsum, (LAS float*)(ldsl + 131072)}; GEMM_PHASE(EpiGate, PanelOrder, g, S, E); } }
DI void phase_wout(const Args& a, LAS unsigned char* ldsl, int l) { PHASE_HEAD
    bf16* MG = (bf16*)(ws + WS_MG);
    Gemm g{MG, wset + W_O, NTOK, 1024, 1024, 1024, 1024}; pg8::StaticOrder S; S.init(NTOK, 1024, G, c);
    EpiResid E{xb, rsum}; GEMM_PHASE(EpiResid, pg8::StaticOrder, g, S, E); }
DI void phase_ffn_in(const Args& a, LAS unsigned char* ldsl, int l) { PHASE_HEAD
    bf16* ACT = (bf16*)(ws + WS_ACT);
    Gemm g{xb, wset + W_FF, NTOK, 2 * DFF, 1024, 1024, 1024}; pg8::StaticOrder S; S.init(NTOK, 2 * DFF, G, c); EpiSwiglu E{ACT, rsum, (LAS float*)(ldsl + 131072)}; GEMM_PHASE(EpiSwiglu, pg8::StaticOrder, g, S, E); }
DI void phase_ffn_out(const Args& a, LAS unsigned char* ldsl, int l) { PHASE_HEAD
    bf16* ACT = (bf16*)(ws + WS_ACT);
    Gemm g{ACT, wset + W_FO, NTOK, 1024, DFF, DFF, DFF}; pg8::StaticOrder S; S.init(NTOK, 1024, G, c);
    EpiResid E{xb, rsum}; GEMM_PHASE(EpiResid, pg8::StaticOrder, g, S, E); }
DI void phase_final(const Args& a) { const int l = 0; PHASE_HEAD
    const int gw = c * 8 + wid, NGW = G * 8; float* out = (float*)a.p[launder_i(16)];
    const GAS f32x4* gn = (const GAS f32x4*)a.p[launder_i(15)] + lane;
    for (int row = 4 * gw; row < NTOK; row += 4 * NGW) {
        const GAS u32x2* xr = (const GAS u32x2*)(xb + (size_t)row * DM) + lane;
        u32x2 w[16];
#pragma unroll
        for (int j = 0; j < 16; ++j) w[j] = xr[64 * j];
        float s[4] = {0.f, 0.f, 0.f, 0.f};
#pragma unroll
        for (int j = 0; j < 16; ++j) { const float e0 = __uint_as_float(w[j].x << 16), e1 = __uint_as_float(w[j].x & 0xffff0000u), e2 = __uint_as_float(w[j].y << 16), e3 = __uint_as_float(w[j].y & 0xffff0000u);
            s[j >> 2] += (e0 * e0 + e1 * e1) + (e2 * e2 + e3 * e3); }
        float r[4];
#pragma unroll
        for (int k = 0; k < 4; ++k) r[k] = rsqrtf(wave_sum(s[k]) * (1.f / 1024.f) + EPS);
        GAS f32x4* o = (GAS f32x4*)(out + (size_t)row * DM) + lane;
#pragma unroll
        for (int j = 0; j < 16; ++j) { f32x4 v; v.x = __uint_as_float(w[j].x << 16); v.y = __uint_as_float(w[j].x & 0xffff0000u); v.z = __uint_as_float(w[j].y << 16); v.w = __uint_as_float(w[j].y & 0xffff0000u);
            o[64 * j] = v * r[j >> 2] * gn[64 * (j & 3)]; }
    } }

__global__ void __launch_bounds__(512, 2) fwd_megakernel(Args a) {
    extern __shared__ __attribute__((aligned(16))) unsigned char lds[];
    cg::grid_group grid = cg::this_grid();
    LAS unsigned char* ldsl = (LAS unsigned char*)lds;
    volatile LAS unsigned* xst = (volatile LAS unsigned*)(ldsl + LDS_BYTES - 64);
    if (threadIdx.x < 2) xst[threadIdx.x] = 0u;
    if (blockIdx.x == 0) { unsigned* bz = (unsigned*)a.p[launder_i(17)]; for (int i = threadIdx.x; i < XCD_BAR_WORDS + 64 * 40; i += 512) bz[i] = 0u; }
    __syncthreads();
    for (int rep = 0; rep < REP_PRO; ++rep) phase_prologue(a, ldsl);
    grid.sync();
    { XcdBarrier xb0 = xcd_barrier_post((unsigned*)a.p[launder_i(17)], xst); (void)xb0; }
#define GSYNC() do { XcdBarrier xb_; xb_.bar = (unsigned*)a.p[launder_i(17)]; xb_.x = xb_xcc_id(); xb_.st = xst; xcd_barrier(xb_); } while (0)
    for (int l = 0; l < DEPTH; ++l) {
        for (int rep = 0; rep < REP_P1; ++rep) { phase_inproj(a, ldsl, l); GSYNC(); }
        for (int rep = 0; rep < REP_P2; ++rep) { phase_compress_a(a, ldsl, l); GSYNC(); }
        for (int rep = 0; rep < REP_P3; ++rep) { phase_attn(a, ldsl, l); GSYNC(); }
        for (int rep = 0; rep < REP_P4; ++rep) { phase_merge(a, ldsl, l); GSYNC(); }
        phase_wout(a, ldsl, l); GSYNC();
        for (int rep = 0; rep < REP_SYNC; ++rep) GSYNC();
        for (int rep = 0; rep < REP_P6; ++rep) { phase_ffn_in(a, ldsl, l); GSYNC(); }
        phase_ffn_out(a, ldsl, l); GSYNC();
    }
    phase_final(a);
}

extern "C" void kernel_launch(void* const* d_in, const int* in_sizes, int n_in, void* d_out, int out_size, void* d_ws, size_t ws_size, hipStream_t stream) {
    static int grid = 0;
    if (grid == 0) {
        if (n_in != 16 || out_size != NTOK * DM || ws_size < WS_END) { fprintf(stderr, "kernel_launch: unexpected problem shape (n_in %d, out %d, ws %zu)\n", n_in, out_size, ws_size); grid = -1; return; }
        int dev = 0, cus = 0, per_cu = 0;
        if (hipGetDevice(&dev) != hipSuccess || hipDeviceGetAttribute(&cus, hipDeviceAttributeMultiprocessorCount, dev) != hipSuccess) { grid = -1; return; }
        if (hipFuncSetAttribute((const void*)fwd_megakernel, hipFuncAttributeMaxDynamicSharedMemorySize, LDS_BYTES) != hipSuccess) { fprintf(stderr, "hipFuncSetAttribute failed\n"); grid = -1; return; }
        if (hipOccupancyMaxActiveBlocksPerMultiprocessor(&per_cu, (const void*)fwd_megakernel, 512, LDS_BYTES) != hipSuccess || per_cu < 1) { fprintf(stderr, "occupancy query: %d\n", per_cu); (void)hipGetLastError(); }
        grid = cus;
        if (grid < 64) { fprintf(stderr, "kernel_launch: too few CUs\n"); grid = -1; return; }
    }
    if (grid < 0) return;
    Args a{};
    for (int i = 0; i < 16; ++i) a.p[i] = (const float*)d_in[i];
    a.p[16] = (const float*)d_out; a.p[17] = (const float*)d_ws;
    void* args[] = {&a};
    hipError_t e = hipLaunchCooperativeKernel((const void*)fwd_megakernel, dim3(grid), dim3(512), args, LDS_BYTES, stream);
    if (e != hipSuccess) fprintf(stderr, "cooperative launch failed: %s (grid %d)\n", hipGetErrorString(e), grid);
}
```

```cpp
#include <hip/hip_runtime.h>
#include <hip/hip_cooperative_groups.h>
#include <cstdio>
#include <cstdint>
namespace cg = cooperative_groups;
namespace pg8 {
#define PG8_LAS __attribute__((address_space(3)))
typedef unsigned short bf16_t;
typedef short bf16x8 __attribute__((ext_vector_type(8)));
typedef float f32x4 __attribute__((ext_vector_type(4)));
typedef unsigned u32x4 __attribute__((ext_vector_type(4)));
constexpr int BM = 256, BK = 64, HALF = 128, HTB = HALF * BK * 2  , STAGE_BYTES = 8 * HTB, NXCD = 8, WGM = 8;

__host__ __device__ __forceinline__ int lds_byte(int r, int c) { const int st = (r >> 4) * 2 + (c >> 5), rr = r & 15, cc = c & 31, ob = rr * 64 + cc * 2; return st * 1024 + (ob ^ (((ob >> 9) & 1) << 5)); }
__host__ __device__ __forceinline__ void stage_rc(int b, int& R, int& C) { const int st = b / 1024, sb = b % 1024, swz = sb ^ (((sb >> 9) & 1) << 5); R = (st >> 1) * 16 + swz / 64; C = (st & 1) * 32 + (swz % 64) / 2; }
__host__ __device__ __forceinline__ int perm32(int rho) { const int n = rho >> 4, i = rho & 15; return 8 * (i >> 2) + 4 * n + (i & 3); }

__device__ __forceinline__ int pg8_tid() { int t = threadIdx.x; asm volatile("" : "+v"(t)); return t; }
struct Unit { int pm, pn; };
struct Gemm { const bf16_t* A; const bf16_t* Bt; int M, N, K, lda, ldb; };

struct StaticOrder {
    int nM, nN, nwg, G, c;
    __host__ __device__ void init(int M, int N, int G_, int c_) { nM = M / BM; nN = N / BM; nwg = nM * nN; G = G_; c = c_; }
    __host__ __device__ bool next(int i, Unit& u) const {
        const long L = (long)i * G + c; if (L >= nwg) return false;
        int wgid = (int)L; { const int q = nwg / NXCD, r = nwg % NXCD, xcd = wgid % NXCD, off = wgid / NXCD; wgid = (xcd < r ? xcd * (q + 1) : r * (q + 1) + (xcd - r) * q) + off; }
        const int nig = WGM * nN, gid = wgid / nig, fm = gid * WGM, gsz = (nM - fm) < WGM ? (nM - fm) : WGM;
        u.pm = fm + ((wgid % nig) % gsz); u.pn = (wgid % nig) / gsz; return true;
    }
    __device__ __forceinline__ void a_ready(const Unit&) const {}
    __device__ __forceinline__ void done(const Unit&) const {}
};
template <class Epi, class Sched, bool ALIGN_EPI = false, bool SP2 = false>
__device__ __forceinline__ void gemm_phase(PG8_LAS unsigned char* lds, const Gemm g, const Sched& S, const Epi& E) {
    const int tid = pg8_tid(), wid = __builtin_amdgcn_readfirstlane(tid >> 6), lane = tid & 63, wr = wid >> 2, wc = wid & 3, fr = lane & 15, fq = lane >> 4;
    const int K = g.K, nt = K / BK;
    unsigned voffA[2], voffB[2];
#pragma unroll
    for (int i = 0; i < 2; ++i) { int R, C; stage_rc(tid * 16 + i * 8192, R, C); const int Rb = Epi::PERM ? ((R & ~31) + perm32(R & 31)) : R;
        voffA[i] = (unsigned)(R * g.lda + C) * 2u; voffB[i] = (unsigned)(Rb * g.ldb + C) * 2u; }
    const size_t kstep = (size_t)(BK * 2);
    const size_t hstepB = (size_t)HALF * g.ldb * 2, hstepA = (size_t)HALF * g.lda * 2;
    const size_t tstepB = 2 * hstepB, tstepA = 2 * hstepA;
    const unsigned ldsw = (unsigned)wid * 1024u;
    const int aoff = lds_byte(wr * 64 + fr, fq * 8), boff = lds_byte(wc * 32 + fr, fq * 8);
#define PG8_SA(b, h) (((b) * 2 + (h)) * HTB)
#define PG8_SB(b, h) ((4 + (b) * 2 + (h)) * HTB)
#define PG8_STAGE(bufoff, gbase, voff) do { _Pragma("unroll") for (int _i = 0; _i < 2; ++_i) \
        __builtin_amdgcn_global_load_lds((const unsigned*)((const char*)(gbase) + (voff)[_i]), (PG8_LAS unsigned*)(lds + (bufoff) + ldsw + _i * 8192), 16, 0, 0); } while (0)
#define PG8_LDA(dst, b, h) do { _Pragma("unroll") for (int m = 0; m < 4; ++m) _Pragma("unroll") for (int k = 0; k < 2; ++k) dst[m][k] = *(const PG8_LAS bf16x8*)(lds + PG8_SA(b, h) + aoff + m * 2048 + k * 1024); } while (0)
#define PG8_LDB(dst, b, h) do { _Pragma("unroll") for (int n = 0; n < 2; ++n) _Pragma("unroll") for (int k = 0; k < 2; ++k) dst[n][k] = *(const PG8_LAS bf16x8*)(lds + PG8_SB(b, h) + boff + n * 2048 + k * 1024); } while (0)
#define PG8_MMA(ai, bj, At, Bt) do { __builtin_amdgcn_s_setprio(1); _Pragma("unroll") for (int m = 0; m < 4; ++m) _Pragma("unroll") for (int n = 0; n < 2; ++n) _Pragma("unroll") for (int k = 0; k < 2; ++k) \
        acc[ai][bj][m][n] = __builtin_amdgcn_mfma_f32_16x16x32_bf16(Bt[n][k], At[m][k], acc[ai][bj][m][n], 0, 0, 0); __builtin_amdgcn_s_setprio(0); } while (0)
#define PG8_WAIT_V(n) asm volatile("s_waitcnt vmcnt(" #n ")" ::: "memory")
#define PG8_WAIT_L(n) asm volatile("s_waitcnt lgkmcnt(" #n ")" ::: "memory")
#define PG8_BAR __builtin_amdgcn_s_barrier()
#define PG8_SCHED __builtin_amdgcn_sched_barrier(0)
    Unit cur, nxt; int ui = 0;
    if (!S.next(0, cur)) return;
    f32x4 acc[2][2][4][2];
#pragma unroll
    for (int a = 0; a < 2; ++a)
#pragma unroll
        for (int b = 0; b < 2; ++b)
#pragma unroll
            for (int m = 0; m < 4; ++m)
#pragma unroll
                for (int n = 0; n < 2; ++n) acc[a][b][m][n] = (f32x4){0.f, 0.f, 0.f, 0.f};
    bf16x8 At[4][2], B0[2][2], B1[2][2];
    const char* cA = (const char*)g.A + (size_t)cur.pm * tstepA; const char* cB = (const char*)g.Bt + (size_t)cur.pn * tstepB;
    S.a_ready(cur);
    if constexpr (SP2) {
        PG8_STAGE(PG8_SB(0, 0), cB, voffB); PG8_STAGE(PG8_SB(0, 1), cB + hstepB, voffB); PG8_STAGE(PG8_SA(0, 0), cA, voffA); PG8_STAGE(PG8_SA(0, 1), cA + hstepA, voffA);
        if (wr == 1) PG8_BAR;
        PG8_WAIT_V(2); PG8_BAR;
        PG8_STAGE(PG8_SB(1, 0), cB + kstep, voffB); PG8_STAGE(PG8_SA(1, 0), cA + kstep, voffA); PG8_STAGE(PG8_SB(1, 1), cB + hstepB + kstep, voffB);
        PG8_WAIT_V(6); PG8_BAR;
    } else {
        PG8_STAGE(PG8_SB(0, 0), cB, voffB); PG8_STAGE(PG8_SA(0, 0), cA, voffA); PG8_STAGE(PG8_SB(0, 1), cB + hstepB, voffB); PG8_STAGE(PG8_SA(0, 1), cA + hstepA, voffA);
        if (wr == 1) PG8_BAR;
        PG8_WAIT_V(4); PG8_BAR;
        PG8_STAGE(PG8_SB(1, 0), cB + kstep, voffB); PG8_STAGE(PG8_SA(1, 0), cA + kstep, voffA); PG8_STAGE(PG8_SB(1, 1), cB + hstepB + kstep, voffB);
        PG8_WAIT_V(6); PG8_BAR;
    }
    for (;;) {
        const bool has_next = S.next(ui + 1, nxt);
        const char* nA = has_next ? (const char*)g.A + (size_t)nxt.pm * tstepA : cA; const char* nB = has_next ? (const char*)g.Bt + (size_t)nxt.pn * tstepB : cB;
        for (int t = 0; t < nt; t += 2) {
            const bool last = (t == nt - 2);
            const char* a1 = cA + (size_t)(t + 1) * kstep;
            const char* a2 = last ? nA : cA + (size_t)(t + 2) * kstep; const char* b2 = last ? nB : cB + (size_t)(t + 2) * kstep;
            const char* a3 = a2 + kstep; const char* b3 = b2 + kstep;
            if (last && has_next) S.a_ready(nxt);
            if constexpr (SP2) {
            PG8_LDB(B0, 0, 0); PG8_LDB(B1, 0, 1); PG8_SCHED; PG8_LDA(At, 0, 0); PG8_STAGE(PG8_SA(1, 1), a1 + hstepA, voffA);
            PG8_WAIT_V(8); PG8_WAIT_L(0); PG8_BAR; PG8_MMA(0, 0, At, B0); PG8_MMA(0, 1, At, B1); PG8_BAR; PG8_SCHED;
            PG8_LDA(At, 0, 1); PG8_STAGE(PG8_SB(0, 0), b2, voffB); PG8_STAGE(PG8_SB(0, 1), b2 + hstepB, voffB); PG8_STAGE(PG8_SA(0, 0), a2, voffA);
            PG8_WAIT_V(8); PG8_WAIT_L(0); PG8_BAR; PG8_MMA(1, 0, At, B0); PG8_MMA(1, 1, At, B1); PG8_BAR; PG8_SCHED;
            PG8_LDB(B0, 1, 0); PG8_LDB(B1, 1, 1); PG8_SCHED; PG8_LDA(At, 1, 0); PG8_STAGE(PG8_SA(0, 1), a2 + hstepA, voffA);
            PG8_WAIT_V(8); PG8_WAIT_L(0); PG8_BAR; PG8_MMA(0, 0, At, B0); PG8_MMA(0, 1, At, B1); PG8_BAR; PG8_SCHED;
            PG8_LDA(At, 1, 1); PG8_STAGE(PG8_SB(1, 0), b3, voffB); PG8_STAGE(PG8_SB(1, 1), b3 + hstepB, voffB); PG8_STAGE(PG8_SA(1, 0), a3, voffA);
            PG8_WAIT_V(8); PG8_WAIT_L(0); PG8_BAR; PG8_MMA(1, 0, At, B0); PG8_MMA(1, 1, At, B1); PG8_BAR; PG8_SCHED;
            } else {
            PG8_LDB(B0, 0, 0); PG8_SCHED; PG8_LDA(At, 0, 0); PG8_STAGE(PG8_SA(1, 1), a1 + hstepA, voffA);
            PG8_WAIT_L(8); PG8_BAR; PG8_WAIT_L(0); PG8_MMA(0, 0, At, B0); PG8_BAR; PG8_SCHED;
            PG8_LDB(B1, 0, 1); PG8_STAGE(PG8_SB(0, 0), b2, voffB);
            PG8_BAR; PG8_WAIT_L(0); PG8_MMA(0, 1, At, B1); PG8_BAR;
            PG8_LDA(At, 0, 1); PG8_STAGE(PG8_SA(0, 0), a2, voffA);
            PG8_BAR; PG8_WAIT_L(0); PG8_MMA(1, 0, At, B0); PG8_BAR; PG8_SCHED;
            PG8_STAGE(PG8_SB(0, 1), b2 + hstepB, voffB);
            PG8_WAIT_V(6); PG8_BAR; PG8_MMA(1, 1, At, B1); PG8_BAR;
            PG8_LDB(B0, 1, 0); PG8_SCHED; PG8_LDA(At, 1, 0); PG8_STAGE(PG8_SA(0, 1), a2 + hstepA, voffA);
            PG8_WAIT_L(8); PG8_BAR; PG8_WAIT_L(0); PG8_MMA(0, 0, At, B0); PG8_BAR; PG8_SCHED;
            PG8_LDB(B1, 1, 1); PG8_STAGE(PG8_SB(1, 0), b3, voffB);
            PG8_BAR; PG8_WAIT_L(0); PG8_MMA(0, 1, At, B1); PG8_BAR;
            PG8_LDA(At, 1, 1); PG8_STAGE(PG8_SA(1, 0), a3, voffA);
            PG8_BAR; PG8_WAIT_L(0); PG8_MMA(1, 0, At, B0); PG8_BAR; PG8_SCHED;
            PG8_STAGE(PG8_SB(1, 1), b3 + hstepB, voffB);
            PG8_WAIT_V(6); PG8_BAR; PG8_MMA(1, 1, At, B1); PG8_BAR;
            }
        }
        if constexpr (ALIGN_EPI) { if (wr == 0) PG8_BAR; }
        if constexpr (!Epi::AFTER_DRAIN) { E(acc, cur, wr, wc, fr, fq); S.done(cur); }
        if (!has_next) break;
#pragma unroll
        for (int a = 0; a < 2; ++a)
#pragma unroll
            for (int b = 0; b < 2; ++b)
#pragma unroll
                for (int m = 0; m < 4; ++m)
#pragma unroll
                    for (int n = 0; n < 2; ++n) acc[a][b][m][n] = (f32x4){0.f, 0.f, 0.f, 0.f};
        cur = nxt; cA = nA; cB = nB; ++ui;
        if constexpr (ALIGN_EPI) { if (wr == 1) PG8_BAR; }
    }
    PG8_WAIT_V(0);
    if constexpr (!ALIGN_EPI) { if (wr == 0) PG8_BAR; }
    PG8_BAR;
    if constexpr (Epi::AFTER_DRAIN) { E.fused(acc, cur, wr, wc, fr, fq, lds, wid, lane); S.done(cur); }
#undef PG8_SA
#undef PG8_SB
#undef PG8_STAGE
#undef PG8_LDA
#undef PG8_LDB
#undef PG8_MMA
#undef PG8_WAIT_V
#undef PG8_WAIT_L
#undef PG8_BAR
#undef PG8_SCHED
}
}
#define DI __device__ __forceinline__
#define GAS __attribute__((address_space(1)))
#define LAS __attribute__((address_space(3)))
typedef unsigned short bf16;
typedef short bf16x8 __attribute__((ext_vector_type(8)));
typedef float f32x4 __attribute__((ext_vector_type(4)));
typedef float f32x16 __attribute__((ext_vector_type(16)));
typedef float f32x2 __attribute__((ext_vector_type(2)));
typedef unsigned u32x4 __attribute__((ext_vector_type(4)));
typedef unsigned u32x2 __attribute__((ext_vector_type(2)));
typedef __bf16 bf2_t __attribute__((ext_vector_type(2)));
using pg8::Unit; using pg8::Gemm;

constexpr int BATCH = 4, SEQ = 8192, DM = 1024, DEPTH = 4, NTOK = BATCH * SEQ, DFF = 2816;
constexpr int D_IN = 5656, N_IN_PAD = 3840, NPR = 57;
constexpr float LOG2E = 1.4426950408889634f, C2 = 0.125f * 1.4426950408889634f, EPS = 1e-6f;
constexpr size_t MiB = 1u << 20;
constexpr size_t WS_RSUM = 1 * MiB, WS_BIAS = 3 * MiB, WS_KC = 4 * MiB, WS_VCT = 4 * MiB + 512 * 1024, WS_H = 5 * MiB;
constexpr size_t WS_W0 = 10 * MiB, WS_W1 = 44 * MiB, WS_XB = 78 * MiB, WS_Y = 142 * MiB, WS_VT = 190 * MiB, WS_PR = 254 * MiB;
constexpr size_t WS_TA = WS_PR, WS_TB = WS_PR + 64 * MiB, WS_MG = WS_PR + 128 * MiB, WS_ACT = WS_PR, WS_PART = 482 * MiB, WS_END = 498 * MiB;
constexpr size_t W_IN = 0, W_G = W_IN + (size_t)3840 * 1024, W_FF = W_G + (size_t)2048 * 1024, W_FO = W_FF + (size_t)5632 * 1024, W_O = W_FO + (size_t)1024 * 2816,
                 W_UA = W_O + (size_t)1024 * 1024, W_UB = W_UA + (size_t)1024 * 512, W_CK1 = W_UB + (size_t)1024 * 256, W_CV1 = W_CK1 + (size_t)256 * 2048,
                 W_CK2 = W_CV1 + (size_t)256 * 2048, W_CV2 = W_CK2 + (size_t)256 * 256, W_TOTAL = W_CV2 + (size_t)256 * 256;
static_assert(W_TOTAL * 2 <= 34 * MiB, "weight set");
constexpr int LDS_BYTES = 163840;

struct Args { const float* p[18]; };

DI unsigned pk2(float lo, float hi) { f32x2 v = {lo, hi}; return __builtin_bit_cast(unsigned, __builtin_convertvector(v, bf2_t)); }
DI float bf2f(unsigned short b) { return __uint_as_float((unsigned)b << 16); }
DI float fast_exp2(float x) { return __builtin_amdgcn_exp2f(x); }
DI float sigmoidf_(float x) { return __builtin_amdgcn_rcpf(1.f + fast_exp2(-x * LOG2E)); }
DI float siluf_(float x) { return x * sigmoidf_(x); }
DI int launder_i(int v) { asm volatile("" : "+s"(v)); return v; }
DI float wave_sum(float v) {
#pragma unroll
    for (int o = 1; o < 64; o <<= 1) v += __shfl_xor(v, o);
    return v;
}
#define LDS_WAIT() asm volatile("s_waitcnt lgkmcnt(0)" ::: "memory")

typedef const f32x4 (&AccRef)[2][2][4][2];
DI float load_rs1(const float* rsum, int row) {
    const GAS f32x4* p = (const GAS f32x4*)(rsum + (size_t)row * 16);
    const f32x4 a = p[0], b = p[1], c = p[2], d = p[3];
    const float s = (((a.x + a.y) + (a.z + a.w)) + ((b.x + b.y) + (b.z + b.w))) + (((c.x + c.y) + (c.z + c.w)) + ((d.x + d.y) + (d.z + d.w)));
    return rsqrtf(s * (1.f / 1024.f) + EPS);
}
DI void unit_rs_table(const float* rsum, int pm, LAS float* rsl) {
    const int tid = pg8::pg8_tid();
    if (tid < 256) rsl[tid] = load_rs1(rsum, pm * 256 + tid);
    asm volatile("s_waitcnt lgkmcnt(0)\n\ts_barrier" ::: "memory");
}
DI void load_rs(const float* rsum, int row0, float (&rs)[2][4]) {
#pragma unroll
    for (int ai = 0; ai < 2; ++ai)
#pragma unroll
        for (int m = 0; m < 4; ++m) {
            const GAS f32x4* p = (const GAS f32x4*)(rsum + (size_t)(row0 + ai * 128 + m * 16) * 16);
            const f32x4 a = p[0], b = p[1], c = p[2], d = p[3];
            const float s = (((a.x + a.y) + (a.z + a.w)) + ((b.x + b.y) + (b.z + b.w))) + (((c.x + c.y) + (c.z + c.w)) + ((d.x + d.y) + (d.z + d.w)));
            rs[ai][m] = rsqrtf(s * (1.f / 1024.f) + EPS);
        }
}
struct EpiProj {
    static constexpr bool PERM = true, AFTER_DRAIN = false;
    bf16* PR; const float* rsum; LAS float* rsl;
    DI void operator()(AccRef acc, const Unit& u, int wr, int wc, int fr, int fq) const {
        const int row0 = u.pm * 256 + wr * 64 + fr;
        unit_rs_table(rsum, u.pm, rsl);
#pragma unroll
        for (int ai = 0; ai < 2; ++ai)
#pragma unroll
            for (int m = 0; m < 4; ++m) {
                const int row = row0 + ai * 128 + m * 16; const float rs = rsl[row - u.pm * 256];
#pragma unroll
                for (int bj = 0; bj < 2; ++bj) {
                    const int c0 = u.pn * 256 + bj * 128 + wc * 32 + 8 * fq, cb = c0 >> 6;
                    if (cb >= NPR) continue;
                    const float sc = (cb < 8 || (cb >= 20 && cb < 32)) ? C2 : 1.f; const bool sig = (cb == 56);
                    const float f = rs * sc;
                    f32x4 v0 = acc[ai][bj][m][0] * f, v1 = acc[ai][bj][m][1] * f;
                    if (sig) { for (int i = 0; i < 4; ++i) { v0[i] = sigmoidf_(v0[i]); v1[i] = sigmoidf_(v1[i]); } }
                    u32x4 w; w.x = pk2(v0[0], v0[1]); w.y = pk2(v0[2], v0[3]); w.z = pk2(v1[0], v1[1]); w.w = pk2(v1[2], v1[3]);
                    if (cb >= 32 && cb < 44) {
                        const int dsh = ((cb - 32) >> 2) * 2, t = row & (SEQ - 1), p = ((t & ((1 << dsh) - 1)) << (13 - dsh)) + (t >> dsh), ch = (c0 & 63) >> 3;
                        *(GAS u32x4*)(PR + ((size_t)cb * NTOK + (size_t)(row - t)) * 64 + (size_t)(p >> 5) * 2048 + ((((ch >> 1) * 32 + (p & 31)) * 2 + (ch & 1)) * 8)) = w;
                    } else
                    *(GAS u32x4*)(PR + ((size_t)cb * NTOK + row) * 64 + (c0 & 63)) = w;
                }
            }
    }
};
template <int ACT> struct EpiBf {
    static constexpr bool PERM = true, AFTER_DRAIN = false;
    bf16* O; int ldc; const float* bias;
    DI void operator()(AccRef acc, const Unit& u, int wr, int wc, int fr, int fq) const {
        const int row0 = u.pm * 256 + wr * 64 + fr;
#pragma unroll
        for (int bj = 0; bj < 2; ++bj) {
            const int c0 = u.pn * 256 + bj * 128 + wc * 32 + 8 * fq;
            f32x4 b0 = {0.f, 0.f, 0.f, 0.f}, b1 = b0;
            if (ACT) { b0 = *(const GAS f32x4*)(bias + c0); b1 = *(const GAS f32x4*)(bias + c0 + 4); }
#pragma unroll
            for (int ai = 0; ai < 2; ++ai)
#pragma unroll
                for (int m = 0; m < 4; ++m) {
                    const int row = row0 + ai * 128 + m * 16;
                    f32x4 v0 = acc[ai][bj][m][0] + b0, v1 = acc[ai][bj][m][1] + b1;
                    if (ACT) { for (int i = 0; i < 4; ++i) { v0[i] = siluf_(v0[i]); v1[i] = siluf_(v1[i]); } }
                    u32x4 w; w.x = pk2(v0[0], v0[1]); w.y = pk2(v0[2], v0[3]); w.z = pk2(v1[0], v1[1]); w.w = pk2(v1[2], v1[3]);
                    *(GAS u32x4*)(O + (size_t)row * ldc + c0) = w;
                }
        }
    }
};
struct EpiCmp {
    static constexpr bool PERM = true, AFTER_DRAIN = false;
    bf16* O; int mode;
    DI void operator()(AccRef acc, const Unit& u, int wr, int wc, int fr, int fq) const {
        if (u.pn != 0 || wc >= 2) return;
        const int row0 = u.pm * 256 + wr * 64 + fr; const int c0 = wc * 32 + 8 * fq;
#pragma unroll
        for (int ai = 0; ai < 2; ++ai)
#pragma unroll
            for (int m = 0; m < 4; ++m) {
                const int row = row0 + ai * 128 + m * 16;
                const f32x4 v0 = acc[ai][0][m][0], v1 = acc[ai][0][m][1];
                if (mode == 0) {
                    u32x4 w; w.x = pk2(v0[0], v0[1]); w.y = pk2(v0[2], v0[3]); w.z = pk2(v1[0], v1[1]); w.w = pk2(v1[2], v1[3]);
                    *(GAS u32x4*)(O + (size_t)row * 64 + c0) = w;
                } else {
                    GAS bf16* p = (GAS bf16*)O + ((size_t)(row >> 9) * 64 + c0) * 512 + (row & 511);
#pragma unroll
                    for (int i = 0; i < 4; ++i) { p[(size_t)i * 512] = (bf16)(pk2(v0[i], 0.f) & 0xffffu); p[(size_t)(4 + i) * 512] = (bf16)(pk2(v1[i], 0.f) & 0xffffu); }
                }
            }
    }
};
struct EpiGate {
    static constexpr bool PERM = true, AFTER_DRAIN = false;
    const bf16* Ta; const bf16* Tb; bf16* MG; const float* rsum; LAS float* rsl;
    DI void operator()(AccRef acc, const Unit& u, int wr, int wc, int fr, int fq) const {
        const int row0 = u.pm * 256 + wr * 64 + fr; const int c0 = u.pn * 128 + wc * 32 + 8 * fq;
        unit_rs_table(rsum, u.pm, rsl);
#pragma unroll
        for (int ai = 0; ai < 2; ++ai) {
            u32x4 ta[4], tb[4];
#pragma unroll
            for (int m = 0; m < 4; ++m) { const size_t off = (size_t)(row0 + ai * 128 + m * 16) * DM + c0; ta[m] = *(const GAS u32x4*)(Ta + off); tb[m] = *(const GAS u32x4*)(Tb + off); }
#pragma unroll
            for (int m = 0; m < 4; ++m) {
                const int row = row0 + ai * 128 + m * 16; const float f = rsl[row - u.pm * 256];
                float o[8];
#pragma unroll
                for (int i = 0; i < 8; ++i) {
                    const float ga = acc[ai][0][m][i >> 2][i & 3] * f, gb = acc[ai][1][m][i >> 2][i & 3] * f;
                    const unsigned wa = ta[m][i >> 1], wb = tb[m][i >> 1];
                    const float a = (i & 1) ? __uint_as_float(wa & 0xffff0000u) : __uint_as_float(wa << 16);
                    const float b = (i & 1) ? __uint_as_float(wb & 0xffff0000u) : __uint_as_float(wb << 16);
                    const float A_ = 1.f + fast_exp2(fminf(-ga * LOG2E, 60.f)), B_ = 1.f + fast_exp2(fminf(-gb * LOG2E, 60.f));
                    o[i] = (a * B_ + b * A_) * __builtin_amdgcn_rcpf(A_ * B_);
                }
                u32x4 w; w.x = pk2(o[0], o[1]); w.y = pk2(o[2], o[3]); w.z = pk2(o[4], o[5]); w.w = pk2(o[6], o[7]);
                *(GAS u32x4*)(MG + (size_t)row * DM + c0) = w;
            }
        }
    }
};
struct EpiSwiglu {
    static constexpr bool PERM = true, AFTER_DRAIN = false;
    bf16* ACT; const float* rsum; LAS float* rsl;
    DI void operator()(AccRef acc, const Unit& u, int wr, int wc, int fr, int fq) const {
        const int row0 = u.pm * 256 + wr * 64 + fr; const int c0 = u.pn * 128 + wc * 32 + 8 * fq;
        unit_rs_table(rsum, u.pm, rsl);
#pragma unroll
        for (int ai = 0; ai < 2; ++ai)
#pragma unroll
            for (int m = 0; m < 4; ++m) {
                const int row = row0 + ai * 128 + m * 16; const float f = rsl[row - u.pm * 256];
                float o[8];
#pragma unroll
                for (int i = 0; i < 8; ++i) { const float gt = acc[ai][0][m][i >> 2][i & 3] * f, up = acc[ai][1][m][i >> 2][i & 3] * f; o[i] = siluf_(gt) * up; }
                u32x4 w; w.x = pk2(o[0], o[1]); w.y = pk2(o[2], o[3]); w.z = pk2(o[4], o[5]); w.w = pk2(o[6], o[7]);
                *(GAS u32x4*)(ACT + (size_t)row * DFF + c0) = w;
            }
    }
};
struct EpiResid {
    static constexpr bool PERM = true, AFTER_DRAIN = false;
    bf16* xb; float* rsum;
    DI void operator()(AccRef acc, const Unit& u, int wr, int wc, int fr, int fq) const {
        const int row0 = u.pm * 256 + wr * 64 + fr;
#pragma unroll
        for (int ai = 0; ai < 2; ++ai) {
            u32x4 xr[4][2];
#pragma unroll
            for (int m = 0; m < 4; ++m)
#pragma unroll
                for (int bj = 0; bj < 2; ++bj) xr[m][bj] = *(const GAS u32x4*)(xb + (size_t)(row0 + ai * 128 + m * 16) * DM + u.pn * 256 + bj * 128 + wc * 32 + 8 * fq);
#pragma unroll
            for (int m = 0; m < 4; ++m) {
                const int row = row0 + ai * 128 + m * 16; float ss = 0.f;
#pragma unroll
                for (int bj = 0; bj < 2; ++bj) {
                    const int c0 = u.pn * 256 + bj * 128 + wc * 32 + 8 * fq; const size_t off = (size_t)row * DM + c0;
                    float v[8];
#pragma unroll
                    for (int i = 0; i < 4; ++i) { v[2 * i] = __uint_as_float(xr[m][bj][i] << 16) + acc[ai][bj][m][(2 * i) >> 2][(2 * i) & 3]; v[2 * i + 1] = __uint_as_float(xr[m][bj][i] & 0xffff0000u) + acc[ai][bj][m][(2 * i + 1) >> 2][(2 * i + 1) & 3]; }
                    u32x4 w; w.x = pk2(v[0], v[1]); w.y = pk2(v[2], v[3]); w.z = pk2(v[4], v[5]); w.w = pk2(v[6], v[7]);
                    *(GAS u32x4*)(xb + off) = w;
#pragma unroll
                    for (int i = 0; i < 4; ++i) { const float lo = __uint_as_float(w[i] << 16), hi_ = __uint_as_float(w[i] & 0xffff0000u); ss += lo * lo + hi_ * hi_; }
                }
                ss += __shfl_xor(ss, 16); ss += __shfl_xor(ss, 32);
                if (fq == 0) rsum[(size_t)row * 16 + u.pn * 4 + wc] = ss;
            }
        }
    }
};
struct EpiF32 {
    static constexpr bool PERM = true, AFTER_DRAIN = false;
    float* O; int ldc;
    DI void operator()(AccRef acc, const Unit& u, int wr, int wc, int fr, int fq) const {
        const int row0 = u.pm * 256 + wr * 64 + fr;
#pragma unroll
        for (int bj = 0; bj < 2; ++bj) {
            const int c0 = u.pn * 256 + bj * 128 + wc * 32 + 8 * fq;
#pragma unroll
            for (int ai = 0; ai < 2; ++ai)
#pragma unroll
                for (int m = 0; m < 4; ++m) { GAS f32x4* p = (GAS f32x4*)(O + (size_t)(row0 + ai * 128 + m * 16) * ldc + c0); p[0] = acc[ai][bj][m][0]; p[1] = acc[ai][bj][m][1]; }
        }
    }
};
struct EpiGa {
    static constexpr bool PERM = true, AFTER_DRAIN = false;
    bf16* PR; const float* rsum;
    DI void operator()(AccRef acc, const Unit& u, int wr, int wc, int fr, int fq) const {
        if (wc != 0 || fq >= 3) return;
        const int row0 = u.pm * 256 + wr * 64 + fr;
#pragma unroll
        for (int ai = 0; ai < 2; ++ai)
#pragma unroll
            for (int m = 0; m < 4; ++m) {
                const int row = row0 + ai * 128 + m * 16; const float f = load_rs1(rsum, row);
                f32x4 v0 = acc[ai][0][m][0] * f, v1 = acc[ai][0][m][1] * f;
#pragma unroll
                for (int i = 0; i < 4; ++i) { v0[i] = sigmoidf_(v0[i]); v1[i] = sigmoidf_(v1[i]); }
                u32x4 w; w.x = pk2(v0[0], v0[1]); w.y = pk2(v0[2], v0[3]); w.z = pk2(v1[0], v1[1]); w.w = pk2(v1[2], v1[3]);
                *(GAS u32x4*)(PR + ((size_t)56 * NTOK + row) * 64 + 8 * fq) = w;
            }
    }
};
struct OneUnit { int pm, pn, has;
    DI bool next(int i, Unit& u) const { if (i > 0 || !has) return false; u.pm = pm; u.pn = pn; return true; }
    DI void a_ready(const Unit&) const {} DI void done(const Unit&) const {} };
struct PanelOrder { int per, G, c;
    DI bool next(int i, Unit& u) const { const int hp = c + (i / per) * G; if (hp >= 2 * (NTOK / 256)) return false; u.pm = hp >> 1; u.pn = (hp & 1) * per + (i % per); return true; }
    DI void a_ready(const Unit&) const {} DI void done(const Unit&) const {} };
#define XB_TMO      128
#define XB_XCNT(j)  (256  + 64 * (j))
#define XB_XSUB(j)  (1280 + 64 * (j))
#define XB_XGEN(j)  (2304 + 64 * (j))
#define XB_TOP      3328
#define XB_TOPGEN   3392
#define XCD_BAR_WORDS 3456
#define XB_SPIN_CAP (1u << 23)

__device__ __forceinline__ unsigned xb_ld(unsigned* p)              { return __hip_atomic_load(p, __ATOMIC_RELAXED, __HIP_MEMORY_SCOPE_AGENT); }
__device__ __forceinline__ unsigned xb_add(unsigned* p, unsigned v) { return __hip_atomic_fetch_add(p, v, __ATOMIC_RELAXED, __HIP_MEMORY_SCOPE_AGENT); }
__device__ __forceinline__ unsigned xb_xcc_id() { return (unsigned)__builtin_amdgcn_s_getreg((3 << 11) | 20) & 0xFu; }
#define XB_SPIN(cond, bar) do { unsigned _sp = 0; while (cond) { __builtin_amdgcn_s_sleep(1); \
    if ((++_sp & 255u) == 0u) { if (xb_ld(&(bar)[XB_TMO])) break; if (_sp > XB_SPIN_CAP) { atomicAdd(&(bar)[XB_TMO], 1u); break; } } } } while (0)

struct XcdBarrier {
    unsigned* bar; unsigned x;
    volatile LAS unsigned* st;
};

__device__ __forceinline__ XcdBarrier xcd_barrier_post(unsigned* bar, volatile LAS unsigned* st) {
    XcdBarrier b; b.bar = bar; b.x = xb_xcc_id(); b.st = st;
    if (threadIdx.x == 0) (void)xb_add(&bar[XB_XCNT(b.x)], 1u);
    return b;
}
__device__ __forceinline__ void xcd_barrier_complete(unsigned* bar, unsigned x, unsigned& nloc, unsigned& nx) {
    const unsigned G = gridDim.x * gridDim.y * gridDim.z;
    unsigned sum, cnt, mine, sp = 0u;
    for (;;) {
        sum = 0u; cnt = 0u; mine = 0u;
#pragma unroll
        for (unsigned j = 0; j < 16; ++j) { const unsigned c = xb_ld(&bar[XB_XCNT(j)]); sum += c; cnt += (c > 0u) ? 1u : 0u; mine = (j == x) ? c : mine; }
        if (sum == G) break;
        __builtin_amdgcn_s_sleep(1);
        if ((++sp & 255u) == 0u) { if (xb_ld(&bar[XB_TMO])) break; if (sp > XB_SPIN_CAP) { atomicAdd(&bar[XB_TMO], 1u); break; } }
    }
    nloc = mine > 0u ? mine : 1u; nx = cnt > 0u ? cnt : 1u;
}

__device__ __forceinline__ void xcd_barrier(const XcdBarrier& b) {
    asm volatile("s_waitcnt vmcnt(0)" ::: "memory");
    __syncthreads();
    if (threadIdx.x == 0) {
        unsigned* bar = b.bar;
        __builtin_amdgcn_s_waitcnt(0);
        unsigned nloc = b.st[0], nx = b.st[1];
        if (nloc == 0u) { xcd_barrier_complete(bar, b.x, nloc, nx); b.st[0] = nloc; b.st[1] = nx; }
        const unsigned old = xb_add(&bar[XB_XSUB(b.x)], 1u);
        const unsigned gen = old / nloc;
        if (old + 1u == (gen + 1u) * nloc) {
            __builtin_amdgcn_fence(__ATOMIC_RELEASE, "agent");
            asm volatile("s_waitcnt vmcnt(0)" ::: "memory");
            const unsigned og = xb_add(&bar[XB_TOP], 1u);
            const unsigned tg = og / nx;
            if (og + 1u == (tg + 1u) * nx) xb_add(&bar[XB_TOPGEN], 1u);
            else XB_SPIN(xb_ld(&bar[XB_TOPGEN]) == tg, bar);
            __builtin_amdgcn_fence(__ATOMIC_ACQUIRE, "agent");
            xb_add(&bar[XB_XGEN(b.x)], 1u);
            asm volatile("s_waitcnt vmcnt(0)" ::: "memory");
        } else {
            XB_SPIN(xb_ld(&bar[XB_XGEN(b.x)]) == gen, bar);
            __builtin_amdgcn_fence(__ATOMIC_ACQUIRE, "agent");
            asm volatile("s_waitcnt vmcnt(0)" ::: "memory");
        }
    }
    __syncthreads();
}
DI int srcmap(int mt, int n) {
    switch (mt) {
        case 0: return n < 1280 ? n : (n < 3584 ? n + 24 : (n < 3608 ? n - 3584 + 1280 : -1));
        case 1: { const int tile = n >> 8, w = n & 255, c = tile * 128 + (w & 127); return 3608 + (w < 128 ? c : 1024 + c); }
        case 2: { const int tile = n >> 8, w = n & 255, c = tile * 128 + (w & 127); return (w < 128) ? c : DFF + c; }
        case 9: case 10: return n < 64 ? n : -1;
        default: return n;
    }
}
DI void cvt_item(const float* W, int Nsrc, int K, const float* gain, int mt, bf16* WT, LAS float* scr, int item, int lane) {
    const int kblks = K >> 6; const int nb = item / kblks, kb = item - nb * kblks; const int k0 = 64 * kb, n0 = 32 * nb;
    const int nn = lane & 31; const int col = srcmap(mt, n0 + nn);
    float vals[32];
#pragma unroll
    for (int i = 0; i < 32; ++i) { const int kk = 2 * i + (lane >> 5); vals[i] = (col >= 0) ? W[(size_t)(k0 + kk) * Nsrc + col] : 0.f; }
    if (gain) {
#pragma unroll
        for (int i = 0; i < 32; ++i) vals[i] *= gain[k0 + 2 * i + (lane >> 5)]; }
#pragma unroll
    for (int i = 0; i < 32; ++i) scr[(2 * i + (lane >> 5)) * 33 + nn] = vals[i];
    LDS_WAIT();
    const int c = lane & 7;
#pragma unroll
    for (int j = 0; j < 4; ++j) { const int n = (lane >> 3) + 8 * j; const LAS float* s = scr + (8 * c) * 33 + n;
        u32x4 o; o.x = pk2(s[0 * 33], s[1 * 33]); o.y = pk2(s[2 * 33], s[3 * 33]); o.z = pk2(s[4 * 33], s[5 * 33]); o.w = pk2(s[6 * 33], s[7 * 33]);
        *(GAS u32x4*)(WT + (size_t)(n0 + n) * K + k0 + 8 * c) = o; }
    LDS_WAIT();
}
constexpr int CVT_ITEMS = 1920 + 1024 + 2816 + 1408 + 512 + 256 + 128 + 256 + 256 + 32 + 32;
DI void convert_layer(const Args& a, int l, bf16* wset, LAS float* scr, int first, int stride, int lane, int it_end = CVT_ITEMS) {
    for (int it = first; it < it_end; it += stride) {
        int r = it, mt, src, Nsrc, K; size_t loff, woff;
        if (r < 1920) { mt = 0; src = 2; Nsrc = D_IN; K = 1024; loff = (size_t)DM * D_IN; woff = W_IN; }
        else if ((r -= 1920) < 1024) { mt = 1; src = 2; Nsrc = D_IN; K = 1024; loff = (size_t)DM * D_IN; woff = W_G; }
        else if ((r -= 1024) < 2816) { mt = 2; src = 13; Nsrc = 2 * DFF; K = 1024; loff = (size_t)DM * 2 * DFF; woff = W_FF; }
        else if ((r -= 2816) < 1408) { mt = 3; src = 14; Nsrc = DM; K = DFF; loff = (size_t)DFF * DM; woff = W_FO; }
        else if ((r -= 1408) < 512) { mt = 4; src = 11; Nsrc = DM; K = 1024; loff = (size_t)DM * DM; woff = W_O; }
        else if ((r -= 512) < 256) { mt = 5; src = 9; Nsrc = DM; K = 512; loff = (size_t)512 * DM; woff = W_UA; }
        else if ((r -= 256) < 128) { mt = 6; src = 10; Nsrc = DM; K = 256; loff = (size_t)256 * DM; woff = W_UB; }
        else if ((r -= 128) < 256) { mt = 7; src = 5; Nsrc = 256; K = 2048; loff = (size_t)2048 * 256; woff = W_CK1; }
        else if ((r -= 256) < 256) { mt = 8; src = 7; Nsrc = 256; K = 2048; loff = (size_t)2048 * 256; woff = W_CV1; }
        else if ((r -= 256) < 32) { mt = 9; src = 6; Nsrc = 64; K = 256; loff = (size_t)256 * 64; woff = W_CK2; }
        else { r -= 32; mt = 10; src = 8; Nsrc = 64; K = 256; loff = (size_t)256 * 64; woff = W_CV2; }
        const float* gain = mt < 2 ? a.p[launder_i(1)] + (size_t)l * DM : (mt == 2 ? a.p[launder_i(12)] + (size_t)l * DM : nullptr);
        cvt_item(a.p[launder_i(src)] + (size_t)l * loff, Nsrc, K, gain, mt, wset + woff, scr, r, lane);
    }
}
DI void x_row_prep4(const float* xrow, bf16* orow, float* rs, int lane) {
    const GAS f32x4* xr = (const GAS f32x4*)xrow + lane; f32x4 v[16]; float s[4] = {0.f, 0.f, 0.f, 0.f};
#pragma unroll
    for (int j = 0; j < 16; ++j) v[j] = xr[64 * j];
#pragma unroll
    for (int j = 0; j < 16; ++j) s[j >> 2] += (v[j].x * v[j].x + v[j].y * v[j].y) + (v[j].z * v[j].z + v[j].w * v[j].w);
#pragma unroll
    for (int k = 0; k < 4; ++k) s[k] = wave_sum(s[k]);
    GAS u32x2* o8 = (GAS u32x2*)orow + lane;
#pragma unroll
    for (int j = 0; j < 16; ++j) { u32x2 w; w.x = pk2(v[j].x, v[j].y); w.y = pk2(v[j].z, v[j].w); o8[64 * j] = w; }
    const float sv = (lane >> 4) == 0 ? s[0] : ((lane >> 4) == 1 ? s[1] : ((lane >> 4) == 2 ? s[2] : s[3]));
    rs[lane] = (lane & 15) == 0 ? sv : 0.f;
}
DI void transpose_task(const bf16* PR, bf16* VT, int task, int lane) {
    const int pgrp = task & 127, b = (task >> 7) & 3, vi = task >> 9;
    const int cb = vi < 4 ? (vi < 2 ? 14 + vi : 16 + vi) : 40 + vi;
    const int dsh = vi < 8 ? 0 : (vi < 12 ? 2 : 4);
    const int Lsh = 13 - dsh;
    const int dg = lane & 7, pg = lane >> 3;
    const int p0 = 64 * pgrp + 8 * pg; const int r = p0 >> Lsh, i0 = p0 & ((1 << Lsh) - 1);
    const GAS bf16* src = (const GAS bf16*)PR + ((size_t)(cb * 4 + b) * SEQ + r) * 64 + 8 * dg;
    u32x4 R[8];
#pragma unroll
    for (int k = 0; k < 8; ++k) R[k] = *(const GAS u32x4*)(src + ((size_t)(i0 + k) << dsh) * 64);
    GAS bf16* dst = (GAS bf16*)VT + ((size_t)((vi * 4 + b) * 64 + 8 * dg)) * SEQ + p0;
    GAS bf16* dstf = (GAS bf16*)VT + ((size_t)(vi * 4 + b) * 64) * SEQ + (size_t)(p0 >> 5) * 2048;
    const int pgt = (p0 >> 3) & 3, s_ = pgt >> 1, half_ = pgt & 1;
#pragma unroll
    for (int j = 0; j < 8; ++j) {
        u32x4 o;
#pragma unroll
        for (int w = 0; w < 4; ++w) o[w] = __builtin_amdgcn_perm(R[2 * w + 1][j >> 1], R[2 * w][j >> 1], (j & 1) ? 0x07060302u : 0x05040100u);
        if (vi < 4) *(GAS u32x4*)(dst + (size_t)j * SEQ) = o;
        else { const int d = 8 * dg + j, d0 = d >> 5, dd = d & 31; GAS u32x2* q = (GAS u32x2*)(dstf + (size_t)((((s_ * 2 + d0) * 2 + half_) * 32 + dd) * 2) * 4);
            u32x2 a, c2; a.x = o.x; a.y = o.y; c2.x = o.z; c2.y = o.w; q[0] = a; q[1] = c2; }
    }
}

#define MFMA32(a, b, c) __builtin_amdgcn_mfma_f32_32x32x16_bf16((a), (b), (c), 0, 0, 0)
DI int crow(int r, int hi) { return (r & 3) + 8 * (r >> 2) + 4 * hi; }
struct KFrag { bf16x8 k[4]; };
struct VFrag { u32x2 v[8]; };
DI void load_k(KFrag& K, const bf16* Kb, int kstride, int r32, int hi) {
    const GAS bf16* p = (const GAS bf16*)Kb + (size_t)r32 * kstride + 8 * hi;
#pragma unroll
    for (int d0 = 0; d0 < 4; ++d0) K.k[d0] = *(const GAS bf16x8*)(p + 16 * d0);
}
DI void load_v(VFrag& V, const bf16* Vt, int vstride, int r32, int hi) {
#pragma unroll
    for (int s = 0; s < 2; ++s)
#pragma unroll
        for (int d0 = 0; d0 < 2; ++d0) {
            const GAS bf16* vp = (const GAS bf16*)Vt + (size_t)(r32 + 32 * d0) * vstride + 16 * s + 4 * hi;
            V.v[(2 * s + d0) * 2] = *(const GAS u32x2*)vp; V.v[(2 * s + d0) * 2 + 1] = *(const GAS u32x2*)(vp + 8);
        }
}
DI void load_kf(KFrag& K, const bf16* tile, int r32, int hi) {
    const GAS bf16* p = (const GAS bf16*)tile + (size_t)(r32 * 2 + hi) * 8;
#pragma unroll
    for (int d0 = 0; d0 < 4; ++d0) K.k[d0] = *(const GAS bf16x8*)(p + d0 * 512);
}
DI void load_vf(VFrag& V, const bf16* tile, int r32, int hi) {
#pragma unroll
    for (int s = 0; s < 2; ++s)
#pragma unroll
        for (int d0 = 0; d0 < 2; ++d0) {
            const GAS u32x2* p = (const GAS u32x2*)((const GAS bf16*)tile + (size_t)((((s * 2 + d0) * 2) * 32 + r32) * 2 + hi) * 4);
            V.v[(2 * s + d0) * 2] = p[0]; V.v[(2 * s + d0) * 2 + 1] = p[64];
        }
}

DI f32x16 qk_frag(const KFrag& K, const bf16x8 (&qf)[4]) {
    f32x16 s;
#pragma unroll
    for (int i = 0; i < 16; ++i) s[i] = 0.f;
#pragma unroll
    for (int d0 = 0; d0 < 4; ++d0) s = MFMA32(K.k[d0], qf[d0], s);
    return s;
}
DI void pv_frag(const VFrag& V, const f32x16& p, f32x16& o0, f32x16& o1) {
#pragma unroll
    for (int s = 0; s < 2; ++s) {
        u32x4 pw; pw.x = pk2(p[8 * s], p[8 * s + 1]); pw.y = pk2(p[8 * s + 2], p[8 * s + 3]); pw.z = pk2(p[8 * s + 4], p[8 * s + 5]); pw.w = pk2(p[8 * s + 6], p[8 * s + 7]);
        const bf16x8 pf = __builtin_bit_cast(bf16x8, pw);
#pragma unroll
        for (int d0 = 0; d0 < 2; ++d0) {
            const u32x2 lo = V.v[(2 * s + d0) * 2], h2 = V.v[(2 * s + d0) * 2 + 1];
            u32x4 vw; vw.x = lo.x; vw.y = lo.y; vw.z = h2.x; vw.w = h2.y;
            const bf16x8 vf = __builtin_bit_cast(bf16x8, vw);
            if (d0 == 0) o0 = MFMA32(vf, pf, o0); else o1 = MFMA32(vf, pf, o1);
        }
    }
}
DI float xhalf(float v) { const auto rr = __builtin_amdgcn_permlane32_swap(__float_as_uint(v), __float_as_uint(v), false, false); return (threadIdx.x & 32) ? __uint_as_float(rr[0]) : __uint_as_float(rr[1]); }
DI float xhalf_max(float v) { const auto rr = __builtin_amdgcn_permlane32_swap(__float_as_uint(v), __float_as_uint(v), false, false); return fmaxf(__uint_as_float(rr[0]), __uint_as_float(rr[1])); }
DI float xhalf_sum(float v) { const auto rr = __builtin_amdgcn_permlane32_swap(__float_as_uint(v), __float_as_uint(v), false, false); return __uint_as_float(rr[0]) + __uint_as_float(rr[1]); }
struct Flash { f32x16 o0, o1; float m, l; };
DI void flash_init(Flash& f) {
#pragma unroll
    for (int i = 0; i < 16; ++i) { f.o0[i] = 0.f; f.o1[i] = 0.f; }
    f.m = -1e20f; f.l = 0.f; }
DI void flash_step(Flash& f, f32x16& sc, const VFrag& V) {
    float mx = sc[0];
#pragma unroll
    for (int r = 1; r < 16; ++r) mx = fmaxf(mx, sc[r]);
    mx = xhalf_max(mx);
    const float mn = fmaxf(f.m, mx); const float alpha = fast_exp2(f.m - mn); f.m = mn;
    float ls = 0.f;
#pragma unroll
    for (int r = 0; r < 16; ++r) { sc[r] = fast_exp2(sc[r] - mn); ls += sc[r]; }
    f.l = f.l * alpha + ls;
    if (__builtin_amdgcn_ballot_w64(alpha != 1.f)) {
#pragma unroll
        for (int r = 0; r < 16; ++r) { f.o0[r] *= alpha; f.o1[r] *= alpha; }
    }
    pv_frag(V, sc, f.o0, f.o1);
}
constexpr int IMP_PITCH = 129;
constexpr int KB_BYTES = 64 * 144, VB_BYTES = 64 * 136, TBUF = KB_BYTES + VB_BYTES;
constexpr int LDS_SELM = 4 * 64 * IMP_PITCH * 4;
constexpr int LDS_INVL = LDS_SELM + 1024, LDS_CBUF = LDS_INVL + 1024, LDS_TB = 0;
static_assert(LDS_CBUF % 16 == 0 && TBUF % 16 == 0 && LDS_CBUF + TBUF <= LDS_BYTES - 64 && 2 * TBUF <= LDS_SELM, "attention LDS map");
struct StageRegs { u32x4 k, v; };
DI void stage_load(StageRegs& R, const bf16* Kb, int kstride, const bf16* Vt, int vstride, int tid, bool withV) {
    const int rw = tid >> 3, ch = tid & 7;
    R.k = *(const GAS u32x4*)((const GAS bf16*)Kb + (size_t)rw * kstride + ch * 8);
    if (withV) R.v = *(const GAS u32x4*)((const GAS bf16*)Vt + (size_t)rw * vstride + ch * 8);
}
DI void stage_store(LAS unsigned char* buf, const StageRegs& R, int tid, bool withV) {
    const int rw = tid >> 3, ch = tid & 7;
    *(LAS u32x4*)(buf + rw * 144 + ch * 16) = R.k;
    if (withV) { LAS u32x2* p = (LAS u32x2*)(buf + KB_BYTES + rw * 136 + ch * 16); u32x2 a, b2; a.x = R.v.x; a.y = R.v.y; b2.x = R.v.z; b2.y = R.v.w; p[0] = a; p[1] = b2; }
}
DI void lds_k(KFrag& K, const LAS unsigned char* buf, int sub, int r32, int hi) {
    const LAS unsigned char* p = buf + (32 * sub + r32) * 144 + 16 * hi;
#pragma unroll
    for (int d0 = 0; d0 < 4; ++d0) K.k[d0] = *(const LAS bf16x8*)(p + 32 * d0);
}
DI void lds_v(VFrag& V, const LAS unsigned char* buf, int sub, int r32, int hi) {
#pragma unroll
    for (int s = 0; s < 2; ++s)
#pragma unroll
        for (int d0 = 0; d0 < 2; ++d0) {
            const LAS unsigned char* p = buf + KB_BYTES + (r32 + 32 * d0) * 136 + (32 * sub + 16 * s + 4 * hi) * 2;
            V.v[(2 * s + d0) * 2] = *(const LAS u32x2*)p; V.v[(2 * s + d0) * 2 + 1] = *(const LAS u32x2*)(p + 16);
        }
}

struct Soft { f32x16 o0, o1; float mref, l; bool seen; };
DI void soft_init(Soft& f) {
#pragma unroll
    for (int i = 0; i < 16; ++i) { f.o0[i] = 0.f; f.o1[i] = 0.f; }
    f.mref = 0.f; f.l = 0.f; f.seen = false; }
DI int ccol(int r) { return (r & 3) + 8 * (r >> 2); }
DI void tile_scores(f32x16& x0, f32x16& x1, const LAS unsigned char* buf, const bf16x8 (&qf)[4], float sk, float aref, int p0, bool laneok, bool needmask, int lo, int hip, int r32, int hi) {
    KFrag K0, K1; lds_k(K0, buf, 0, r32, hi); lds_k(K1, buf, 1, r32, hi);
    const float B = laneok ? fmaf(sk, (float)(p0 + 4 * hi), -aref) : -1e30f;
    const float B1 = B + 32.f * sk;
#pragma unroll
    for (int r = 0; r < 16; ++r) { x0[r] = fmaf(sk, (float)ccol(r), B); x1[r] = fmaf(sk, (float)ccol(r), B1); }
#pragma unroll
    for (int d0 = 0; d0 < 4; ++d0) { x0 = MFMA32(K0.k[d0], qf[d0], x0); x1 = MFMA32(K1.k[d0], qf[d0], x1); }
    if (needmask) {
#pragma unroll
        for (int r = 0; r < 16; ++r) { const int pos = p0 + crow(r, hi); if (pos < lo || pos > hip) x0[r] = -1e30f; if (pos + 32 < lo || pos + 32 > hip) x1[r] = -1e30f; }
    }
}
DI float soft_update(Soft& f, f32x16& x0, f32x16& x1, bool hasO) {
    float mx = fmaxf(x0[0], x1[0]);
#pragma unroll
    for (int r = 1; r < 16; ++r) mx = fmaxf(mx, fmaxf(x0[r], x1[r]));
    mx = xhalf_max(mx);
    const bool valid = mx > -1e20f;
    const bool need = valid && (mx > 8.f || !f.seen);
    float dmove = 0.f;
    if (__builtin_amdgcn_ballot_w64(need)) {
        const float delta = need ? fmaxf(mx, -60.f) : 0.f; const float sc = fast_exp2(-delta);
        dmove = delta;
        f.mref += delta; f.l *= sc;
        if (hasO) {
#pragma unroll
            for (int r = 0; r < 16; ++r) { f.o0[r] *= sc; f.o1[r] *= sc; } }
#pragma unroll
        for (int r = 0; r < 16; ++r) { x0[r] -= delta; x1[r] -= delta; }
    }
    f.seen = f.seen || valid;
    float ls = 0.f;
#pragma unroll
    for (int r = 0; r < 16; ++r) { x0[r] = fast_exp2(x0[r]); x1[r] = fast_exp2(x1[r]); ls += x0[r] + x1[r]; }
    f.l += ls;
    return dmove;
}
DI void tile_pv(Soft& f, const LAS unsigned char* buf, const f32x16& p0v, const f32x16& p1v, int r32, int hi) {
    VFrag V0, V1; lds_v(V0, buf, 0, r32, hi); lds_v(V1, buf, 1, r32, hi);
    pv_frag(V0, p0v, f.o0, f.o1); pv_frag(V1, p1v, f.o0, f.o1);
}
DI void tile_pv2(Soft& f, const VFrag& V0, const VFrag& V1, const f32x16& p0v, const f32x16& p1v) { pv_frag(V0, p0v, f.o0, f.o1); pv_frag(V1, p1v, f.o0, f.o1); }

DI void frag_scores(f32x16& x0, const KFrag& K0, const bf16x8 (&qf)[4], float sk, float aref, int p0, bool needmask, int lo, int hip, int hi) {
    const float B = fmaf(sk, (float)(p0 + 4 * hi), -aref);
#pragma unroll
    for (int r = 0; r < 16; ++r) x0[r] = fmaf(sk, (float)ccol(r), B);
#pragma unroll
    for (int d0 = 0; d0 < 4; ++d0) x0 = MFMA32(K0.k[d0], qf[d0], x0);
    if (needmask) {
#pragma unroll
        for (int r = 0; r < 16; ++r) { const int pos = p0 + crow(r, hi); if (pos < lo || pos > hip) x0[r] = -1e30f; }
    }
}
DI void soft_update1(Soft& f, f32x16& x0) {
    float mx = x0[0];
#pragma unroll
    for (int r = 1; r < 16; ++r) mx = fmaxf(mx, x0[r]);
    mx = xhalf_max(mx);
    const bool valid = mx > -1e20f;
    const bool need = valid && (mx > 8.f || !f.seen);
    if (__builtin_amdgcn_ballot_w64(need)) {
        const float delta = need ? fmaxf(mx, -60.f) : 0.f; const float sc = fast_exp2(-delta);
        f.mref += delta; f.l *= sc;
#pragma unroll
        for (int r = 0; r < 16; ++r) { f.o0[r] *= sc; f.o1[r] *= sc; x0[r] -= delta; }
    }
    f.seen = f.seen || valid;
    float ls = 0.f;
#pragma unroll
    for (int r = 0; r < 16; ++r) { x0[r] = fast_exp2(x0[r]); ls += x0[r]; }
    f.l += ls;
}

DI void nsa_unit(const bf16* PR, const bf16* VT, const bf16* kcb, const bf16* vctb, bf16* Y, LAS unsigned char* lds, int b, int g, int jt) {
    const int tid = pg8::pg8_tid(), lane = tid & 63, r32 = lane & 31, hi = lane >> 5, wid = __builtin_amdgcn_readfirstlane(tid >> 6);
    const int hq = wid & 3, th = wid >> 2, h = 4 * g + hq;
    const int tl = 32 * th + r32, t = 64 * jt + tl; const size_t row = (size_t)b * SEQ + t;
    const int tw0 = 64 * jt + 32 * th;
    const float slope2 = exp2f(-0.4f * (float)(9 + h)) * LOG2E;
    bf16x8 qf[4];
    { const GAS bf16* qp = (const GAS bf16*)PR + ((size_t)h * NTOK + row) * 64 + 8 * hi;
#pragma unroll
      for (int d0 = 0; d0 < 4; ++d0) qf[d0] = *(const GAS bf16x8*)(qp + 16 * d0); }
    float g0, g1, g2;
    { const GAS bf16* gp = (const GAS bf16*)PR + ((size_t)56 * NTOK + row) * 64 + h * 3; g0 = bf2f(gp[0]); g1 = bf2f(gp[1]); g2 = bf2f(gp[2]); }
    LAS float* imp = (LAS float*)lds; LAS unsigned* selm = (LAS unsigned*)(lds + LDS_SELM); LAS float* invl = (LAS float*)(lds + LDS_INVL); LAS unsigned char* tb = lds + LDS_TB;
    { LAS float* zr = imp + (size_t)(tid >> 1) * IMP_PITCH;
      for (int j = tid & 1; j <= jt; j += 2) zr[j] = 0.f; }
    f32x16 acc0, acc1;
    StageRegs R;
    {
        const bf16* kc = kcb + (size_t)(g * 4 + b) * 512 * 64; const bf16* vct = vctb + (size_t)(g * 4 + b) * 64 * 512;
        const int nq = (t >= 31) ? ((t - 31) >> 4) : -1;
        const int nhi_w = 4 * jt + 2 * th;
        const int nqmin = (tw0 >= 31) ? ((tw0 - 31) >> 4) : -1;
        const int ncmp = ((4 * jt + 2) >> 6) + 1;
        const float sk = 16.f * slope2, ab = slope2 * (float)(t - 31);
        Soft f; soft_init(f);
        LAS unsigned char* cbuf = lds + LDS_CBUF;
        LAS float* impw = imp + ((size_t)hq * 64 + tl) * IMP_PITCH;
        stage_load(R, kc + (size_t)(ncmp - 1) * 64 * 64, 64, vct + 64 * (ncmp - 1), 512, tid, true); stage_store(cbuf, R, tid, true); __syncthreads();
        for (int i = ncmp - 1; i >= 0; --i) {
            if (i > 0) stage_load(R, kc + (size_t)(i - 1) * 64 * 64, 64, vct + 64 * (i - 1), 512, tid, true);
            if (64 * i <= nhi_w) {
                VFrag V0, V1; lds_v(V0, cbuf, 0, r32, hi); lds_v(V1, cbuf, 1, r32, hi);
                f32x16 x0, x1; tile_scores(x0, x1, cbuf, qf, sk, ab + f.mref, 64 * i, true, 64 * i + 63 > nqmin, -(1 << 30), nq, r32, hi);
                const bool had = f.seen;
                const float dl = soft_update(f, x0, x1, true);
                if (__builtin_amdgcn_ballot_w64(had && dl != 0.f)) {
                    const float sc = (had && dl != 0.f) ? fast_exp2(-dl) : 1.f;
                    for (int j = hi; j < 128; j += 2) impw[j] *= sc;
                }
#pragma unroll
                for (int a = 0; a < 4; ++a) { const int j = 16 * i + 2 * a + hi; const float h3 = 0.5f * x0[4 * a + 3], h3b = 0.5f * x1[4 * a + 3];
                    __hip_atomic_fetch_add(impw + j, (x0[4 * a] + x0[4 * a + 1]) + (x0[4 * a + 2] + h3), __ATOMIC_RELAXED, __HIP_MEMORY_SCOPE_WORKGROUP);
                    __hip_atomic_fetch_add(impw + j + 1, h3, __ATOMIC_RELAXED, __HIP_MEMORY_SCOPE_WORKGROUP);
                    __hip_atomic_fetch_add(impw + j + 8, (x1[4 * a] + x1[4 * a + 1]) + (x1[4 * a + 2] + h3b), __ATOMIC_RELAXED, __HIP_MEMORY_SCOPE_WORKGROUP);
                    if (j + 9 <= 127) __hip_atomic_fetch_add(impw + j + 9, h3b, __ATOMIC_RELAXED, __HIP_MEMORY_SCOPE_WORKGROUP); }
                tile_pv2(f, V0, V1, x0, x1);
            }
            __syncthreads();
            if (i > 0) { stage_store(cbuf, R, tid, true); __syncthreads(); }
        }
        const float l = xhalf_sum(f.l);
        const float inv_l = l > 0.f ? 1.f / l : 0.f;
        if (hi == 0) invl[hq * 64 + tl] = inv_l;
        const float gs = g0 * inv_l;
#pragma unroll
        for (int i = 0; i < 16; ++i) { acc0[i] = gs * f.o0[i]; acc1[i] = gs * f.o1[i]; }
    }
    __syncthreads();
    {
        const int tok = 8 * wid + (lane >> 3), sub = lane & 7;
        float v[16]; unsigned selbits = 0u;
#pragma unroll
        for (int k = 0; k < 16; ++k) { const int j = 16 * sub + k;
            const bool valid = j <= jt, forced = (j == 0) || (j == jt) || (j == jt - 1);
            float s = -1.f;
            if (valid && !forced) s = (imp[((size_t)0 * 64 + tok) * IMP_PITCH + j] * invl[0 * 64 + tok] + imp[((size_t)1 * 64 + tok) * IMP_PITCH + j] * invl[1 * 64 + tok])
                                    + (imp[((size_t)2 * 64 + tok) * IMP_PITCH + j] * invl[2 * 64 + tok] + imp[((size_t)3 * 64 + tok) * IMP_PITCH + j] * invl[3 * 64 + tok]);
            if (valid && (forced || jt < 16)) selbits |= 1u << k;
            v[k] = s; }
        if (jt >= 16) {
            for (int round = 0; round < 13; ++round) {
                float bv = -1.f; int bj = 1 << 20;
#pragma unroll
                for (int k = 0; k < 16; ++k) { if (v[k] > bv) { bv = v[k]; bj = 16 * sub + k; } }
#define SEL_DPP_STEP(ctrl_) do { const float ov = __uint_as_float((unsigned)__builtin_amdgcn_mov_dpp((int)__float_as_uint(bv), ctrl_, 0xf, 0xf, true)); const int oj = __builtin_amdgcn_mov_dpp(bj, ctrl_, 0xf, 0xf, true); \
                    if (ov > bv || (ov == bv && oj < bj)) { bv = ov; bj = oj; } } while (0)
                SEL_DPP_STEP(0xB1); SEL_DPP_STEP(0x4E); SEL_DPP_STEP(0x141);
#undef SEL_DPP_STEP
                if ((bj >> 4) == sub) {
#pragma unroll
                    for (int k = 0; k < 16; ++k) if (k == (bj & 15)) { v[k] = -1.f; selbits |= 1u << k; }
                }
            }
        }
        ((LAS unsigned short*)selm)[tok * 8 + sub] = (unsigned short)selbits;
    }
    __syncthreads();
    {
        unsigned mk0, mk1, mk2, mk3, wu0, wu1, wu2, wu3, gu0, gu1, gu2, gu3;
        { unsigned mk[4], wu[4], gu[4];
#pragma unroll
          for (int w = 0; w < 4; ++w) { mk[w] = selm[tl * 4 + w]; unsigned u = mk[w];
#pragma unroll
              for (int off = 1; off < 32; off <<= 1) u |= (unsigned)__shfl_xor((int)u, off);
              wu[w] = __builtin_amdgcn_readfirstlane(u);
              unsigned u2 = selm[lane * 4 + w];
#pragma unroll
              for (int off = 1; off < 64; off <<= 1) u2 |= (unsigned)__shfl_xor((int)u2, off);
              gu[w] = __builtin_amdgcn_readfirstlane(u2); }
          mk0 = mk[0]; mk1 = mk[1]; mk2 = mk[2]; mk3 = mk[3]; wu0 = wu[0]; wu1 = wu[1]; wu2 = wu[2]; wu3 = wu[3]; gu0 = gu[0]; gu1 = gu[1]; gu2 = gu[2]; gu3 = gu[3]; }
        Soft f; soft_init(f);
        const bf16* ks = PR + ((size_t)(12 + g) * NTOK + (size_t)b * SEQ) * 64; const bf16* vst = VT + ((size_t)(g * 4 + b) * 64) * SEQ;
        const float ab = slope2 * (float)t;
        int itw = 3; unsigned itbits = gu3;
#define SEL_NEXT(j_) do { j_ = -1; while (itbits == 0u && itw > 0) { --itw; itbits = itw == 2 ? gu2 : (itw == 1 ? gu1 : gu0); } \
            if (itbits != 0u) { const int jb_ = 31 - __builtin_clz(itbits); itbits &= ~(1u << jb_); j_ = 32 * itw + jb_; } } while (0)
        int jcur; SEL_NEXT(jcur);
        stage_load(R, ks + (size_t)jcur * 64 * 64, 64, vst + 64 * jcur, SEQ, tid, true); stage_store(tb, R, tid, true); __syncthreads();
        int par = 0;
        while (jcur >= 0) {
            int jnext; SEL_NEXT(jnext);
            if (jnext >= 0) stage_load(R, ks + (size_t)jnext * 64 * 64, 64, vst + 64 * jnext, SEQ, tid, true);
            const LAS unsigned char* buf = tb + par * TBUF;
            const int jw = jcur >> 5, jb = jcur & 31;
            const unsigned wuw = jw == 0 ? wu0 : (jw == 1 ? wu1 : (jw == 2 ? wu2 : wu3));
            if ((wuw >> jb) & 1u) {
                const unsigned mw = jw == 0 ? mk0 : (jw == 1 ? mk1 : (jw == 2 ? mk2 : mk3));
                const bool mysel = (mw >> jb) & 1u;
                VFrag V0, V1; lds_v(V0, buf, 0, r32, hi); lds_v(V1, buf, 1, r32, hi);
                f32x16 x0, x1; tile_scores(x0, x1, buf, qf, slope2, ab + f.mref, 64 * jcur, mysel, jcur == jt, -(1 << 30), t, r32, hi);
                soft_update(f, x0, x1, true);
                tile_pv2(f, V0, V1, x0, x1);
            }
            if (jnext >= 0) stage_store(tb + (par ^ 1) * TBUF, R, tid, true);
            __syncthreads();
            par ^= 1; jcur = jnext;
        }
#undef SEL_NEXT
        const float l = xhalf_sum(f.l); const float sc_ = l > 0.f ? g1 / l : 0.f;
#pragma unroll
        for (int i = 0; i < 16; ++i) { acc0[i] += sc_ * f.o0[i]; acc1[i] += sc_ * f.o1[i]; }
    }
    {
        Soft f; soft_init(f);
        const bf16* kw = PR + ((size_t)(16 + g) * NTOK + (size_t)b * SEQ) * 64; const bf16* vwt = VT + ((size_t)((2 + g) * 4 + b) * 64) * SEQ;
        const float ab = slope2 * (float)t;
        const int kfirst = jt >= 8 ? 64 * (jt - 8) : 0, klast = 64 * jt;
        stage_load(R, kw + (size_t)klast * 64, 64, vwt + klast, SEQ, tid, true); stage_store(tb, R, tid, true); __syncthreads();
        int par = 0;
        for (int kt = klast; kt >= kfirst; kt -= 64) {
            if (kt - 64 >= kfirst) stage_load(R, kw + (size_t)(kt - 64) * 64, 64, vwt + kt - 64, SEQ, tid, true);
            const LAS unsigned char* buf = tb + par * TBUF;
            if (kt + 63 >= tw0 - 511) {
                const bool needmask = (kt + 63 > tw0) || (kt < tw0 + 31 - 511);
                VFrag V0, V1; lds_v(V0, buf, 0, r32, hi); lds_v(V1, buf, 1, r32, hi);
                f32x16 x0, x1; tile_scores(x0, x1, buf, qf, slope2, ab + f.mref, kt, true, needmask, t - 511, t, r32, hi);
                soft_update(f, x0, x1, true);
                tile_pv2(f, V0, V1, x0, x1);
            }
            if (kt - 64 >= kfirst) stage_store(tb + (par ^ 1) * TBUF, R, tid, true);
            __syncthreads();
            par ^= 1;
        }
        const float l = xhalf_sum(f.l); const float sc_ = l > 0.f ? g2 / l : 0.f;
#pragma unroll
        for (int i = 0; i < 16; ++i) { acc0[i] += sc_ * f.o0[i]; acc1[i] += sc_ * f.o1[i]; }
    }
    { GAS bf16* yp = (GAS bf16*)Y + row * 768 + h * 64 + 4 * hi;
#pragma unroll
      for (int a = 0; a < 4; ++a) {
          u32x2 w0; w0.x = pk2(acc0[4 * a], acc0[4 * a + 1]); w0.y = pk2(acc0[4 * a + 2], acc0[4 * a + 3]); *(GAS u32x2*)(yp + 8 * a) = w0;
          u32x2 w1; w1.x = pk2(acc1[4 * a], acc1[4 * a + 1]); w1.y = pk2(acc1[4 * a + 2], acc1[4 * a + 3]); *(GAS u32x2*)(yp + 32 + 8 * a) = w1; } }
}

constexpr int DIL_YOFF = 4096, DIL_YPITCH = 136;
static_assert(DIL_YOFF + 512 * DIL_YPITCH <= LDS_BYTES - 64, "dilated-unit LDS map");
DI void dil_unit(const bf16* PR, const bf16* VT, bf16* Y, LAS unsigned char* lds, int b, int hh, int tb) {
    const int tid = pg8::pg8_tid(), lane = tid & 63, r32 = lane & 31, hi = lane >> 5, wid = __builtin_amdgcn_readfirstlane(tid >> 6);
    LAS float* lser = (LAS float*)lds; LAS unsigned char* yl = lds + DIL_YOFF;
    for (int gidx = 0; gidx < 3; ++gidx) {
        const int dsh = 2 * gidx, dil = 1 << dsh, nsub = 16 >> dsh, L = SEQ >> dsh;
        const int kidx = gidx < 2 ? 1 + 4 * gidx + hh : 17 + hh;
        const float slope2d = exp2f(-0.4f * (float)kidx) * LOG2E * (float)dil;
        for (int wt = wid; wt < 16; wt += 8) {
            const int r = wt / nsub, sb = wt - r * nsub; const int i0 = ((512 * tb) >> dsh) + 32 * sb; const int i = i0 + r32; const int t = r + (i << dsh);
            const size_t row = (size_t)b * SEQ + t;
            bf16x8 qf[4];
            { const GAS bf16* qp = (const GAS bf16*)PR + ((size_t)(20 + gidx * 4 + hh) * NTOK + row) * 64 + 8 * hi;
#pragma unroll
              for (int d0 = 0; d0 < 4; ++d0) qf[d0] = *(const GAS bf16x8*)(qp + 16 * d0); }
            const bf16* kpl = PR + ((size_t)(32 + gidx * 4 + hh) * NTOK + (size_t)b * SEQ) * 64;
            const bf16* vpl = VT + ((size_t)(((4 + gidx * 4 + hh) * 4 + b) * 64)) * SEQ; const int pr = r * L;
            Soft f; soft_init(f);
            const int ipf = i0 - 128 < 0 ? 0 : i0 - 128;
            const float ab = slope2d * (float)i;
            KFrag Kq[3]; VFrag Vq[3];
#define DIL_LOAD(slot, s_) do { const int ip_ = i0 - 32 * (s_) >= ipf ? i0 - 32 * (s_) : ipf; const size_t to_ = (size_t)((pr + ip_) >> 5) * 2048; load_kf(Kq[slot], kpl + to_, r32, hi); load_vf(Vq[slot], vpl + to_, r32, hi); } while (0)
            DIL_LOAD(0, 0); DIL_LOAD(1, 1);
#pragma unroll
            for (int s = 0; s < 5; ++s) {
                if (s + 2 < 5) DIL_LOAD((s + 2) % 3, s + 2);
                const int ip0 = i0 - 32 * s;
                if (ip0 >= ipf) {
                    f32x16 x; frag_scores(x, Kq[s % 3], qf, slope2d, ab + f.mref, ip0, s == 0 || s == 4, i - 128, i, hi);
                    soft_update1(f, x);
                    pv_frag(Vq[s % 3], x, f.o0, f.o1);
                }
            }
#undef DIL_LOAD
            const float l = xhalf_sum(f.l); const float inv = 1.f / l; const float lse2 = f.mref + __builtin_amdgcn_logf(l);
            const int tloc = t - 512 * tb;
            LAS unsigned char* yp = yl + tloc * DIL_YPITCH + 8 * hi;
            float wa = 0.f, wb = inv, lnew = lse2;
            if (gidx > 0) { const float Lr = lser[tloc]; const float M = fmaxf(Lr, lse2); const float ea = fast_exp2(Lr - M), eb = fast_exp2(lse2 - M); const float den = 1.f / (ea + eb);
                wa = ea * den; wb = eb * den * inv; lnew = M + __builtin_amdgcn_logf(ea + eb); }
#pragma unroll
            for (int a = 0; a < 4; ++a)
#pragma unroll
                for (int d0 = 0; d0 < 2; ++d0) {
                    LAS u32x2* p = (LAS u32x2*)(yp + 64 * d0 + 16 * a);
                    float o[4];
#pragma unroll
                    for (int k = 0; k < 4; ++k) o[k] = wb * (d0 ? f.o1[4 * a + k] : f.o0[4 * a + k]);
                    if (gidx > 0) { const u32x2 y = *p; o[0] += wa * __uint_as_float(y.x << 16); o[1] += wa * __uint_as_float(y.x & 0xffff0000u); o[2] += wa * __uint_as_float(y.y << 16); o[3] += wa * __uint_as_float(y.y & 0xffff0000u); }
                    u32x2 w; w.x = pk2(o[0], o[1]); w.y = pk2(o[2], o[3]); *p = w;
                }
            if (hi == 0) lser[tloc] = lnew;
        }
        __syncthreads();
    }
    { const size_t rowb = (size_t)b * SEQ + 512 * tb;
#pragma unroll
      for (int k = 0; k < 8; ++k) { const int tok = (tid >> 3) + 64 * k, ch = tid & 7;
          const LAS u32x2* p = (const LAS u32x2*)(yl + tok * DIL_YPITCH + ch * 16); const u32x2 a = p[0], c2 = p[1];
          u32x4 w; w.x = a.x; w.y = a.y; w.z = c2.x; w.w = c2.y;
          *(GAS u32x4*)((GAS bf16*)Y + (rowb + tok) * 768 + 512 + hh * 64 + ch * 8) = w; } }
    __syncthreads();
}
#ifndef REP_PRO
#define REP_PRO 1
#endif
constexpr int CVT_SPLIT = 5120;
#ifndef REP_P1
#define REP_P1 1
#endif
#ifndef REP_P2
#define REP_P2 1
#endif
#ifndef REP_P3
#define REP_P3 1
#endif
#ifndef REP_P4
#define REP_P4 1
#endif
#ifndef REP_P6
#define REP_P6 1
#endif
#ifndef REP_SYNC
#define REP_SYNC 0
#endif
#ifndef REP_NSA
#define REP_NSA 1
#endif
#ifndef REP_DIL
#define REP_DIL 1
#endif
#define GEMM_PHASE(EpiT, SchedT, g, S, E) pg8::gemm_phase<EpiT, SchedT, true, true>(ldsl, g, S, E)
#define PHASE_HEAD const int G = launder_i((int)gridDim.x), c = launder_i((int)blockIdx.x); unsigned char* ws = (unsigned char*)a.p[launder_i(17)]; (void)G; (void)c; \
    const int tid = pg8::pg8_tid(), lane = tid & 63, wid = __builtin_amdgcn_readfirstlane(tid >> 6); (void)lane; (void)wid; \
    bf16* wset = (bf16*)(ws + ((l & 1) ? WS_W1 : WS_W0)); (void)wset; float* rsum = (float*)(ws + WS_RSUM); (void)rsum; bf16* xb = (bf16*)(ws + WS_XB); (void)xb; bf16* PR = (bf16*)(ws + WS_PR); (void)PR;

DI void phase_prologue(const Args& a, LAS unsigned char* ldsl) { const int l = 0; PHASE_HEAD
    const int gw = c * 8 + wid, NGW = G * 8; float* bias1 = (float*)(ws + WS_BIAS);
    LAS float* scr = (LAS float*)(ldsl + wid * 16384);
    convert_layer(a, 0, (bf16*)(ws + WS_W0), scr, gw, NGW, lane, 1920);
    convert_layer(a, 0, (bf16*)(ws + WS_W0), scr, 8064 + gw, NGW, lane, CVT_ITEMS);
    for (int row = 4 * gw; row < NTOK; row += 4 * NGW) x_row_prep4(a.p[launder_i(0)] + (size_t)row * DM, xb + (size_t)row * DM, rsum + (size_t)row * 16, lane);
    for (int task = gw; task < DEPTH * 2 * 256; task += NGW) {
        const int col = task & 255, kv = (task >> 8) & 1, ll = task >> 9;
        const float* pe = a.p[launder_i(kv ? 4 : 3)] + (size_t)ll * 2048; const float* w1 = a.p[launder_i(kv ? 7 : 5)] + (size_t)ll * 2048 * 256;
        float s = 0.f; float wv[32];
#pragma unroll
        for (int i = 0; i < 32; ++i) wv[i] = w1[(size_t)(lane + 64 * i) * 256 + col];
#pragma unroll
        for (int i = 0; i < 32; ++i) s += pe[lane + 64 * i] * wv[i];
        s = wave_sum(s);
        if (lane == 0) bias1[task] = s;
    }
}
DI void phase_inproj(const Args& a, LAS unsigned char* ldsl, int l) { PHASE_HEAD
    Gemm g{xb, wset + W_IN, NTOK, 3584, 1024, 1024, 1024}; pg8::StaticOrder S; S.init(NTOK, 3584, G, c); EpiProj E{PR, rsum, (LAS float*)(ldsl + 131072)};
    GEMM_PHASE(EpiProj, pg8::StaticOrder, g, S, E); }
DI void phase_compress_a(const Args& a, LAS unsigned char* ldsl, int l) { PHASE_HEAD
    bf16* VT = (bf16*)(ws + WS_VT); float* part = (float*)(ws + WS_PART);
    if (c < 64) {
        const int kv = c >> 5, kh = (c >> 4) & 1, pm = c & 15;
        Gemm g{PR + (size_t)(8 + 2 * kv) * NTOK * 64 + kh * 1024, wset + (kv ? W_CV1 : W_CK1) + kh * 1024, 4096, 256, 1024, 1024, 2048}; OneUnit S{pm, 0, 1};
        EpiF32 E{part + (size_t)(kv * 2 + kh) * 4096 * 256, 256};
        GEMM_PHASE(EpiF32, OneUnit, g, S, E);
    } else {
        { Gemm g{xb, wset + W_IN + (size_t)3584 * 1024, NTOK, 256, 1024, 1024, 1024}; OneUnit S{c - 64, 0, (c - 64) < NTOK / 256 ? 1 : 0}; EpiGa E{PR, rsum};
          GEMM_PHASE(EpiGa, OneUnit, g, S, E); }
        if (c >= 192) { for (int task = (c - 192) * 8 + wid; task < 5888; task += 2 * 64 * 8) { transpose_task(PR, VT, task, lane); if (task + 64 * 8 < 5888) transpose_task(PR, VT, task + 64 * 8, lane); } }
        else { for (int task = 5888 + (c - 64) * 8 + wid; task < 16 * 4 * 128; task += 128 * 8) transpose_task(PR, VT, task, lane); }
    } }
DI void phase_attn(const Args& a, LAS unsigned char* ldsl, int l) { PHASE_HEAD
    float* bias1 = (float*)(ws + WS_BIAS); bf16* kcb = (bf16*)(ws + WS_KC); bf16* vctb = (bf16*)(ws + WS_VCT); bf16* Hb = (bf16*)(ws + WS_H); const float* part = (const float*)(ws + WS_PART);
    bf16* VT = (bf16*)(ws + WS_VT); bf16* Y = (bf16*)(ws + WS_Y);
    unsigned* flag = (unsigned*)ws + XCD_BAR_WORDS + 64 * (32 + l);
    if (c < 32) {
        const int kv = c >> 4, pm = c & 15;
        { const GAS f32x4* p0 = (const GAS f32x4*)(part + (size_t)(kv * 2) * 4096 * 256 + (size_t)pm * 256 * 256); const GAS f32x4* p1 = p0 + (size_t)4096 * 256 / 4;
          const GAS f32x4* bs = (const GAS f32x4*)(bias1 + (size_t)(l * 2 + kv) * 256); GAS u32x2* ho = (GAS u32x2*)(Hb + (size_t)kv * 4096 * 256 + (size_t)pm * 256 * 256);
          const f32x4 bv = bs[tid & 63];
          for (int i0 = tid; i0 < 256 * 256 / 4; i0 += 512 * 8) {
              f32x4 va[8], vb[8];
#pragma unroll
              for (int k = 0; k < 8; ++k) { va[k] = p0[i0 + 512 * k]; vb[k] = p1[i0 + 512 * k]; }
#pragma unroll
              for (int k = 0; k < 8; ++k) { const f32x4 v = va[k] + vb[k] + bv;
                  u32x2 w; w.x = pk2(siluf_(v[0]), siluf_(v[1])); w.y = pk2(siluf_(v[2]), siluf_(v[3])); ho[i0 + 512 * k] = w; } } }
        __builtin_amdgcn_fence(__ATOMIC_RELEASE, "workgroup"); __syncthreads(); __builtin_amdgcn_fence(__ATOMIC_ACQUIRE, "workgroup");
        { Gemm g{Hb + (size_t)kv * 4096 * 256, wset + (kv ? W_CV2 : W_CK2), 4096, 256, 256, 256, 256}; OneUnit S{pm, 0, 1};
          EpiCmp E{kv ? vctb : kcb, kv};
          GEMM_PHASE(EpiCmp, OneUnit, g, S, E); }
        asm volatile("s_waitcnt vmcnt(0)" ::: "memory");
        __syncthreads();
        if (tid == 0) { __builtin_amdgcn_fence(__ATOMIC_RELEASE, "agent"); asm volatile("s_waitcnt vmcnt(0)" ::: "memory");
            (void)__hip_atomic_fetch_add(flag, 1u, __ATOMIC_RELAXED, __HIP_MEMORY_SCOPE_AGENT); }
    }
    const int xq = c & 7;
    unsigned* ctr = (unsigned*)ws + XCD_BAR_WORDS + 64 * (8 * l + xq);
    volatile LAS int* qslot = (volatile LAS int*)(ldsl + LDS_BYTES - 32);
    const int nitems = 160 + ((l + 1 < DEPTH) ? 16 : 0) + (l == 0 ? 16 : 0);
    bool kc_ready = false;
    for (;;) {
        if (tid == 0) *qslot = (int)__hip_atomic_fetch_add(ctr, 1u, __ATOMIC_RELAXED, __HIP_MEMORY_SCOPE_AGENT);
        __syncthreads();
        const int q = __builtin_amdgcn_readfirstlane(*qslot);
        __syncthreads();
        if (q >= nitems) break;
        if (q < 32) { const int pl = 2 * xq + (q >> 4); dil_unit(PR, VT, Y, ldsl, pl >> 2, pl & 3, q & 15); }
        else if (q < 160) {
            if (!kc_ready) {
                if (tid == 0) { unsigned sp = 0u;
                    while (__hip_atomic_load(flag, __ATOMIC_RELAXED, __HIP_MEMORY_SCOPE_AGENT) < 32u) { __builtin_amdgcn_s_sleep(1); if (++sp > (1u << 24)) break; }
                    __builtin_amdgcn_fence(__ATOMIC_ACQUIRE, "agent"); asm volatile("s_waitcnt vmcnt(0)" ::: "memory"); }
                __syncthreads();
                kc_ready = true;
            }
            nsa_unit(PR, VT, kcb, vctb, Y, ldsl, xq >> 1, xq & 1, 159 - q);
        } else if (l == 0 && q >= 176) {
            const int gch = xq * 16 + (q - 176); const int i0 = 1920 + gch * 48, i1 = i0 + 48 < 8064 ? i0 + 48 : 8064;
            LAS float* scr = (LAS float*)(ldsl + wid * 16384);
            convert_layer(a, 0, (bf16*)(ws + WS_W0), scr, i0 + wid, 8, lane, i1);
            __syncthreads();
        } else {
            const int gch = xq * 16 + (q - 160); const int i0 = gch * 68, i1 = i0 + 68 < CVT_ITEMS ? i0 + 68 : CVT_ITEMS;
            LAS float* scr = (LAS float*)(ldsl + wid * 16384);
            convert_layer(a, l + 1, (bf16*)(ws + (((l + 1) & 1) ? WS_W1 : WS_W0)), scr, i0 + wid, 8, lane, i1);
            __syncthreads();
        }
    } }
DI void phase_merge(const Args& a, LAS unsigned char* ldsl, int l) { PHASE_HEAD
    bf16* Y = (bf16*)(ws + WS_Y); bf16* Ta = (bf16*)(ws + WS_TA); bf16* Tb = (bf16*)(ws + WS_TB); bf16* MG = (bf16*)(ws + WS_MG);
    { Gemm g{Y, wset + W_UA, NTOK, 1024, 512, 768, 512}; PanelOrder S{2, G, c}; EpiBf<0> E{Ta, DM, nullptr}; GEMM_PHASE(EpiBf<0>, PanelOrder, g, S, E); }
    { Gemm g{Y + 512, wset + W_UB, NTOK, 1024, 256, 768, 256}; PanelOrder S{2, G, c}; EpiBf<0> E{Tb, DM, nullptr}; GEMM_PHASE(EpiBf<0>, PanelOrder, g, S, E); }
    { Gemm g{xb, wset + W_G, NTOK, 2048, 1024, 1024, 1024}; PanelOrder S{4, G, c}; EpiGate E{Ta, Tb, MG, rsum, (LAS float*)(ldsl + 131072)}; GEMM_PHASE(EpiGate, PanelOrder, g, S, E); } }
DI void phase_wout(const Args& a, LAS unsigned char* ldsl, int l) { PHASE_HEAD
    bf16* MG = (bf16*)(ws + WS_MG);
    Gemm g{MG, wset + W_O, NTOK, 1024, 1024, 1024, 1024}; pg8::StaticOrder S; S.init(NTOK, 1024, G, c);
    EpiResid E{xb, rsum}; GEMM_PHASE(EpiResid, pg8::StaticOrder, g, S, E); }
DI void phase_ffn_in(const Args& a, LAS unsigned char* ldsl, int l) { PHASE_HEAD
    bf16* ACT = (bf16*)(ws + WS_ACT);
    Gemm g{xb, wset + W_FF, NTOK, 2 * DFF, 1024, 1024, 1024}; pg8::StaticOrder S; S.init(NTOK, 2 * DFF, G, c); EpiSwiglu E{ACT, rsum, (LAS float*)(ldsl + 131072)}; GEMM_PHASE(EpiSwiglu, pg8::StaticOrder, g, S, E); }
DI void phase_ffn_out(const Args& a, LAS unsigned char* ldsl, int l) { PHASE_HEAD
    bf16* ACT = (bf16*)(ws + WS_ACT);
    Gemm g{ACT, wset + W_FO, NTOK, 1024, DFF, DFF, DFF}; pg8::StaticOrder S; S.init(NTOK, 1024, G, c);
    EpiResid E{xb, rsum}; GEMM_PHASE(EpiResid, pg8::StaticOrder, g, S, E); }
DI void phase_final(const Args& a) { const int l = 0; PHASE_HEAD
    const int gw = c * 8 + wid, NGW = G * 8; float* out = (float*)a.p[launder_i(16)];
    const GAS f32x4* gn = (const GAS f32x4*)a.p[launder_i(15)] + lane;
    for (int row = 4 * gw; row < NTOK; row += 4 * NGW) {
        const GAS u32x2* xr = (const GAS u32x2*)(xb + (size_t)row * DM) + lane;
        u32x2 w[16];
#pragma unroll
        for (int j = 0; j < 16; ++j) w[j] = xr[64 * j];
        float s[4] = {0.f, 0.f, 0.f, 0.f};
#pragma unroll
        for (int j = 0; j < 16; ++j) { const float e0 = __uint_as_float(w[j].x << 16), e1 = __uint_as_float(w[j].x & 0xffff0000u), e2 = __uint_as_float(w[j].y << 16), e3 = __uint_as_float(w[j].y & 0xffff0000u);
            s[j >> 2] += (e0 * e0 + e1 * e1) + (e2 * e2 + e3 * e3); }
        float r[4];
#pragma unroll
        for (int k = 0; k < 4; ++k) r[k] = rsqrtf(wave_sum(s[k]) * (1.f / 1024.f) + EPS);
        GAS f32x4* o = (GAS f32x4*)(out + (size_t)row * DM) + lane;
#pragma unroll
        for (int j = 0; j < 16; ++j) { f32x4 v; v.x = __uint_as_float(w[j].x << 16); v.y = __uint_as_float(w[j].x & 0xffff0000u); v.z = __uint_as_float(w[j].y << 16); v.w = __uint_as_float(w[j].y & 0xffff0000u);
            o[64 * j] = v * r[j >> 2] * gn[64 * (j & 3)]; }
    } }

__global__ void __launch_bounds__(512, 2) fwd_megakernel(Args a) {
    extern __shared__ __attribute__((aligned(16))) unsigned char lds[];
    cg::grid_group grid = cg::this_grid();
    LAS unsigned char* ldsl = (LAS unsigned char*)lds;
    volatile LAS unsigned* xst = (volatile LAS unsigned*)(ldsl + LDS_BYTES - 64);
    if (threadIdx.x < 2) xst[threadIdx.x] = 0u;
    if (blockIdx.x == 0) { unsigned* bz = (unsigned*)a.p[launder_i(17)]; for (int i = threadIdx.x; i < XCD_BAR_WORDS + 64 * 40; i += 512) bz[i] = 0u; }
    __syncthreads();
    for (int rep = 0; rep < REP_PRO; ++rep) phase_prologue(a, ldsl);
    grid.sync();
    { XcdBarrier xb0 = xcd_barrier_post((unsigned*)a.p[launder_i(17)], xst); (void)xb0; }
#define GSYNC() do { XcdBarrier xb_; xb_.bar = (unsigned*)a.p[launder_i(17)]; xb_.x = xb_xcc_id(); xb_.st = xst; xcd_barrier(xb_); } while (0)
    for (int l = 0; l < DEPTH; ++l) {
        for (int rep = 0; rep < REP_P1; ++rep) { phase_inproj(a, ldsl, l); GSYNC(); }
        for (int rep = 0; rep < REP_P2; ++rep) { phase_compress_a(a, ldsl, l); GSYNC(); }
        for (int rep = 0; rep < REP_P3; ++rep) { phase_attn(a, ldsl, l); GSYNC(); }
        for (int rep = 0; rep < REP_P4; ++rep) { phase_merge(a, ldsl, l); GSYNC(); }
        phase_wout(a, ldsl, l); GSYNC();
        for (int rep = 0; rep < REP_SYNC; ++rep) GSYNC();
        for (int rep = 0; rep < REP_P6; ++rep) { phase_ffn_in(a, ldsl, l); GSYNC(); }
        phase_ffn_out(a, ldsl, l); GSYNC();
    }
    phase_final(a);
}

extern "C" void kernel_launch(void* const* d_in, const int* in_sizes, int n_in, void* d_out, int out_size, void* d_ws, size_t ws_size, hipStream_t stream) {
    static int grid = 0;
    if (grid == 0) {
        if (n_in != 16 || out_size != NTOK * DM || ws_size < WS_END) { fprintf(stderr, "kernel_launch: unexpected problem shape (n_in %d, out %d, ws %zu)\n", n_in, out_size, ws_size); grid = -1; return; }
        int dev = 0, cus = 0, per_cu = 0;
        if (hipGetDevice(&dev) != hipSuccess || hipDeviceGetAttribute(&cus, hipDeviceAttributeMultiprocessorCount, dev) != hipSuccess) { grid = -1; return; }
        if (hipFuncSetAttribute((const void*)fwd_megakernel, hipFuncAttributeMaxDynamicSharedMemorySize, LDS_BYTES) != hipSuccess) { fprintf(stderr, "hipFuncSetAttribute failed\n"); grid = -1; return; }
        if (hipOccupancyMaxActiveBlocksPerMultiprocessor(&per_cu, (const void*)fwd_megakernel, 512, LDS_BYTES) != hipSuccess || per_cu < 1) { fprintf(stderr, "occupancy query: %d\n", per_cu); (void)hipGetLastError(); }
        grid = cus;
        if (grid < 64) { fprintf(stderr, "kernel_launch: too few CUs\n"); grid = -1; return; }
    }
    if (grid < 0) return;
    Args a{};
    for (int i = 0; i < 16; ++i) a.p[i] = (const float*)d_in[i];
    a.p[16] = (const float*)d_out; a.p[17] = (const float*)d_ws;
    void* args[] = {&a};
    hipError_t e = hipLaunchCooperativeKernel((const void*)fwd_megakernel, dim3(grid), dim3(512), args, LDS_BYTES, stream);
    if (e != hipSuccess) fprintf(stderr, "cooperative launch failed: %s (grid %d)\n", hipGetErrorString(e), grid);
}
```
